# Optimizing an MI355X kernel written in HIP

```python
import jax, jax.numpy as jnp
from jax import lax
import numpy as np

D_MODEL = 1024
BATCH = 4
SEQ = 8192
DEPTH = 4

GRID_W = 64
CTX_LEN = 256
RET_HEADS = 4
RET_DK = 128
RET_DV = 256
RET_QK = RET_HEADS * RET_DK
RET_WIDTH = RET_HEADS * RET_DV
CONV_WIDTH = D_MODEL // 2
CONV_K = 3
MIX_WIDTH = RET_WIDTH + CONV_WIDTH
IN_WIDTH = 2 * RET_QK + 2 * RET_WIDTH + 3 * CONV_WIDTH
CHUNK = 128
N_EXPERTS = 32
TOP_K = 4
D_FF = D_MODEL
SWIGLU_LIMIT = 7.0
SWIGLU_ALPHA = 1.702
EXPERT_BLOCK = 256
ROPE_BASE = 10000.0
EPS = 1e-6

kernel_name = "hybrid_retention_shortconv_moe_dit"


def _rmsnorm(x, g):
    xf = x.astype(jnp.float32)
    y = xf * lax.rsqrt(jnp.mean(xf * xf, axis=-1, keepdims=True) + EPS)
    return (y * g.astype(jnp.float32)).astype(x.dtype)


def _modulate(x, g, shift, scale):
    return _rmsnorm(x, g) * (1 + scale) + shift


def _rope_1d(x, pos):
    m = x.shape[-1] // 2
    freqs = ROPE_BASE ** (-jnp.arange(m, dtype=jnp.float32) / m)
    ang = pos.astype(jnp.float32)[:, None] * freqs[None, :]
    cos, sin = jnp.cos(ang).astype(x.dtype), jnp.sin(ang).astype(x.dtype)
    x1, x2 = x[..., :m], x[..., m:]
    return jnp.concatenate([x1 * cos - x2 * sin, x1 * sin + x2 * cos], axis=-1)


def _rope_2d(x, n_tokens):
    t = jnp.arange(n_tokens, dtype=jnp.int32)
    half = x.shape[-1] // 2
    return jnp.concatenate([_rope_1d(x[..., :half], t // GRID_W),
                            _rope_1d(x[..., half:], t % GRID_W)], axis=-1)


def _heads(a, d):
    b, l, _ = a.shape
    return a.reshape(b, l, RET_HEADS, d).transpose(0, 2, 1, 3)


def _project(p):
    q, k, v, g, cb, cc, cx = jnp.split(
        p, [RET_QK, 2 * RET_QK, 2 * RET_QK + RET_WIDTH, 2 * RET_QK + 2 * RET_WIDTH,
            2 * RET_QK + 2 * RET_WIDTH + CONV_WIDTH,
            2 * RET_QK + 2 * RET_WIDTH + 2 * CONV_WIDTH], axis=-1)
    return _heads(q, RET_DK), _heads(k, RET_DK), _heads(v, RET_DV), g, cb, cc, cx


def _chunk_states(kc, vc, lg, s0):
    i = jnp.arange(CHUNK, dtype=jnp.float32)
    k_decay = jnp.exp((CHUNK - 1 - i)[None, :] * lg[:, None]).astype(kc.dtype)
    chunk_decay = jnp.exp(CHUNK * lg)[None, :, None, None]
    kv = jnp.einsum('bhncd,hc,bhnce->nbhde', kc, k_decay, vc).astype(jnp.float32)

    def step(s, kv_n):
        return chunk_decay * s + kv_n, s

    s_final, s_prev = lax.scan(step, s0, kv)
    return s_prev, s_final


def _retention_dir(q, k, v, lg, s0, strict):
    b, h, n, dk = q.shape
    nc = n // CHUNK
    qc = q.reshape(b, h, nc, CHUNK, dk)
    kc = k.reshape(b, h, nc, CHUNK, dk)
    vc = v.reshape(b, h, nc, CHUNK, v.shape[-1])
    s_prev, s_final = _chunk_states(kc, vc, lg, s0)
    i = jnp.arange(CHUNK, dtype=jnp.float32)
    diff = i[:, None] - i[None, :]
    keep = (diff > 0) if strict else (diff >= 0)
    dmask = jnp.where(keep[None], jnp.exp(jnp.where(keep, diff, 0.0)[None] * lg[:, None, None]),
                      0.0).astype(q.dtype)
    scores = jnp.einsum('bhncd,bhnsd->bhncs', qc, kc) * dmask[:, None]
    inner = jnp.einsum('bhncs,bhnse->bhnce', scores, vc).astype(jnp.float32)
    q_decay = jnp.exp((i + 1)[None, :] * lg[:, None])
    cross = jnp.einsum('bhncd,hc,nbhde->bhnce', qc.astype(jnp.float32), q_decay, s_prev)
    return (inner + cross).reshape(b, h, n, -1), s_final


def _flip(a):
    return a[:, :, ::-1]


def _bidir_retention(q, k, v, lg_f, lg_b, s0_f, s0_b):
    out_f, s_f = _retention_dir(q, k, v, lg_f, s0_f, False)
    out_b, s_b = _retention_dir(_flip(q), _flip(k), _flip(v), lg_b, s0_b, True)
    return out_f + _flip(out_b), s_f, s_b


def _context_states(k, v, lg_f, lg_b, s0):
    b, h, l, dk = k.shape
    nc = l // CHUNK
    kc = k.reshape(b, h, nc, CHUNK, dk)
    vc = v.reshape(b, h, nc, CHUNK, v.shape[-1])
    _, s_f = _chunk_states(kc, vc, lg_f, s0)
    _, s_b = _chunk_states(kc[:, :, ::-1, ::-1], vc[:, :, ::-1, ::-1], lg_b, s0)
    return s_f, s_b


def _retention_readout(y, g):
    y = y * lax.rsqrt(jnp.mean(y * y, axis=-1, keepdims=True) + EPS)
    b, h, n, dv = y.shape
    y = y.transpose(0, 2, 1, 3).reshape(b, n, h * dv).astype(g.dtype)
    return jax.nn.silu(g) * y


def _conv3(u, w):
    pad = [(0, 0)] * (u.ndim - 2) + [(1, 1), (0, 0)]
    up = jnp.pad(u, pad)
    l = u.shape[-2]
    return up[..., :l, :] * w[0] + up[..., 1:l + 1, :] * w[1] + up[..., 2:, :] * w[2]


def _moe(h, router_w, router_b, w_up, b_up, w_down, b_down):
    t, d = h.shape
    logits = (h @ router_w + router_b).astype(jnp.float32)
    top_v, top_i = lax.top_k(logits, TOP_K)
    wts = jax.nn.softmax(top_v, axis=-1).astype(h.dtype)
    a = t * TOP_K
    e_flat = top_i.reshape(a).astype(jnp.int32)
    tok_flat = jnp.repeat(jnp.arange(t, dtype=jnp.int32), TOP_K)
    w_flat = wts.reshape(a)
    order = jnp.argsort(e_flat)
    e_s, tok_s, w_s = e_flat[order], tok_flat[order], w_flat[order]
    counts = jnp.bincount(e_flat, length=N_EXPERTS)
    starts = jnp.cumsum(counts) - counts
    padded = (counts + EXPERT_BLOCK - 1) // EXPERT_BLOCK * EXPERT_BLOCK
    pend = jnp.cumsum(padded)
    pstarts = pend - padded
    dest = pstarts[e_s] + (jnp.arange(a, dtype=jnp.int32) - starts[e_s])
    nb = -(-a // EXPERT_BLOCK) + N_EXPERTS
    p = nb * EXPERT_BLOCK
    buf_tok = jnp.full((p,), t, dtype=jnp.int32).at[dest].set(tok_s)
    buf_w = jnp.zeros((p,), h.dtype).at[dest].set(w_s)
    block_e = jnp.clip(jnp.searchsorted(pend, jnp.arange(nb, dtype=jnp.int32) * EXPERT_BLOCK,
                                        side='right'), 0, N_EXPERTS - 1)
    h_pad = jnp.concatenate([h, jnp.zeros((1, d), h.dtype)], axis=0)
    xb = h_pad[buf_tok].reshape(nb, EXPERT_BLOCK, d)

    def expert_block(args):
        xblk, e = args
        u = xblk @ w_up[e] + b_up[e]
        gate = jnp.minimum(u[:, :D_FF], SWIGLU_LIMIT)
        lin = jnp.clip(u[:, D_FF:], -SWIGLU_LIMIT, SWIGLU_LIMIT)
        act = gate * jax.nn.sigmoid(SWIGLU_ALPHA * gate) * (lin + 1)
        return act @ w_down[e] + b_down[e]

    yb = lax.map(expert_block, (xb, block_e)).reshape(p, d)
    y = jax.ops.segment_sum(yb * buf_w[:, None], buf_tok, num_segments=t + 1)
    return y[:t]


def setup_inputs(seed: int = 0) -> dict:
    key = jax.random.key(seed)
    ks = jax.random.split(key, 20)
    D = D_MODEL
    f32 = jnp.float32

    def nrm(k, shape, scale):
        return jax.random.normal(k, shape, f32) * scale

    gamma0 = 1.0 - 2.0 ** (-5.0 - jnp.arange(RET_HEADS, dtype=f32))
    logit0 = jnp.log(gamma0) - jnp.log1p(-gamma0)
    return {
        "x": nrm(ks[0], (BATCH, SEQ, D), 1.0),
        "c": nrm(ks[1], (BATCH, D), 1.0),
        "ctx": nrm(ks[2], (BATCH, CTX_LEN, D), 1.0),
        "c_ctx": nrm(ks[3], (D,), 1.0),
        "w_mod": nrm(ks[4], (DEPTH, D, 6 * D), 0.5 * D ** -0.5),
        "b_mod": nrm(ks[5], (DEPTH, 6 * D), 0.02),
        "norm_mix": 1.0 + nrm(ks[6], (DEPTH, D), 0.02),
        "norm_ffn": 1.0 + nrm(ks[7], (DEPTH, D), 0.02),
        "w_in": nrm(ks[8], (DEPTH, D, IN_WIDTH), D ** -0.5),
        "ret_decay_f": logit0[None, :] + nrm(ks[9], (DEPTH, RET_HEADS), 0.1),
        "ret_decay_b": logit0[None, :] + nrm(ks[10], (DEPTH, RET_HEADS), 0.1),
        "conv_w": nrm(ks[11], (DEPTH, CONV_K, CONV_WIDTH), CONV_K ** -0.5),
        "w_out": nrm(ks[12], (DEPTH, MIX_WIDTH, D), MIX_WIDTH ** -0.5),
        "router_w": nrm(ks[13], (DEPTH, D, N_EXPERTS), D ** -0.5),
        "router_b": nrm(ks[14], (DEPTH, N_EXPERTS), 0.01),
        "w_up": nrm(ks[15], (DEPTH, N_EXPERTS, D, 2 * D_FF), D ** -0.5),
        "b_up": nrm(ks[16], (DEPTH, N_EXPERTS, 2 * D_FF), 0.02),
        "w_down": nrm(ks[17], (DEPTH, N_EXPERTS, D_FF, D), D_FF ** -0.5),
        "b_down": nrm(ks[18], (DEPTH, N_EXPERTS, D), 0.02),
        "norm_final": 1.0 + nrm(ks[19], (D,), 0.02),
    }


def reference(x, c, ctx, c_ctx, w_mod, b_mod, norm_mix, norm_ffn, w_in, ret_decay_f,
              ret_decay_b, conv_w, w_out, router_w, router_b, w_up, b_up, w_down, b_down,
              norm_final):
    b, n, d = x.shape
    rows = n // GRID_W
    lc = ctx.shape[1]
    silu_c = jax.nn.silu(c)
    silu_cc = jax.nn.silu(c_ctx)
    q_scale = RET_DK ** -0.5
    s_zero = jnp.zeros((b, RET_HEADS, RET_DK, RET_DV), jnp.float32)
    for layer in range(DEPTH):
        last = layer == DEPTH - 1
        mod_lat = (silu_c @ w_mod[layer] + b_mod[layer])[:, None, :]
        mod_ctx = silu_cc @ w_mod[layer] + b_mod[layer]
        sh1, sc1, g1, sh2, sc2, g2 = jnp.split(mod_lat, 6, axis=-1)
        csh1, csc1, cg1, csh2, csc2, cg2 = jnp.split(mod_ctx, 6, axis=-1)
        lg_f = jax.nn.log_sigmoid(ret_decay_f[layer].astype(jnp.float32))
        lg_b = jax.nn.log_sigmoid(ret_decay_b[layer].astype(jnp.float32))

        h = _modulate(x, norm_mix[layer], sh1, sc1)
        hc = _modulate(ctx, norm_mix[layer], csh1, csc1)
        q, k, v, g, cb, cc, cx = _project(h @ w_in[layer])
        q = _rope_2d(q, n) * q_scale
        k = _rope_2d(k, n)
        if last:
            kv_c = hc @ w_in[layer][:, RET_QK:2 * RET_QK + RET_WIDTH]
            k_c = _heads(kv_c[..., :RET_QK], RET_DK)
            v_c = _heads(kv_c[..., RET_QK:], RET_DV)
            s_f, s_b = _context_states(k_c, v_c, lg_f, lg_b, s_zero)
        else:
            q_c, k_c, v_c, g_c, cb_c, cc_c, cx_c = _project(hc @ w_in[layer])
            y_c, s_f, s_b = _bidir_retention(q_c * q_scale, k_c, v_c, lg_f, lg_b, s_zero, s_zero)
            ret_c = _retention_readout(y_c, g_c)
            conv_c = cb_c * _conv3(cc_c * cx_c, conv_w[layer])
            mix_c = jnp.concatenate([ret_c, conv_c], axis=-1) @ w_out[layer]
        y_l, _, _ = _bidir_retention(q, k, v, lg_f, lg_b, s_f, s_b)
        ret_l = _retention_readout(y_l, g)
        u = (cc * cx).reshape(b, rows, GRID_W, CONV_WIDTH)
        conv_l = cb * _conv3(u, conv_w[layer]).reshape(b, n, CONV_WIDTH)
        mix_l = jnp.concatenate([ret_l, conv_l], axis=-1) @ w_out[layer]
        x = x + g1 * mix_l
        if not last:
            ctx = ctx + cg1 * mix_c

        h2 = _modulate(x, norm_ffn[layer], sh2, sc2).reshape(b * n, d)
        if last:
            y2 = _moe(h2, router_w[layer], router_b[layer], w_up[layer], b_up[layer],
                      w_down[layer], b_down[layer])
            x = x + g2 * y2.reshape(b, n, d)
        else:
            hc2 = _modulate(ctx, norm_ffn[layer], csh2, csc2).reshape(b * lc, d)
            y2 = _moe(jnp.concatenate([h2, hc2], axis=0), router_w[layer], router_b[layer],
                      w_up[layer], b_up[layer], w_down[layer], b_down[layer])
            x = x + g2 * y2[:b * n].reshape(b, n, d)
            ctx = ctx + cg2 * y2[b * n:].reshape(b, lc, d)
    return _rmsnorm(x, norm_final)
```

```cpp
#include <hip/hip_runtime.h>
#include <cstdio>
#include <cstdint>
#ifndef MK_MULTI
#define MK_MULTI 0
#endif
#ifndef MK_CHECK
#define MK_CHECK 0
#endif
namespace pg8 {
#define PG8_LAS __attribute__((address_space(3)))
typedef unsigned short bf16_t;
typedef short bf16x8 __attribute__((ext_vector_type(8)));
typedef float f32x4 __attribute__((ext_vector_type(4)));
typedef unsigned u32x4 __attribute__((ext_vector_type(4)));
constexpr int BM = 256, BK = 64, HALF = 128, HTB = HALF * BK * 2  , STAGE_BYTES = 8 * HTB, NXCD = 8, WGM = 8;

__host__ __device__ __forceinline__ int lds_byte(int r, int c) { const int st = (r >> 4) * 2 + (c >> 5), rr = r & 15, cc = c & 31, ob = rr * 64 + cc * 2; return st * 1024 + (ob ^ (((ob >> 9) & 1) << 5)); }
__host__ __device__ __forceinline__ void stage_rc(int b, int& R, int& C) { const int st = b / 1024, sb = b % 1024, swz = sb ^ (((sb >> 9) & 1) << 5); R = (st >> 1) * 16 + swz / 64; C = (st & 1) * 32 + (swz % 64) / 2; }
__host__ __device__ __forceinline__ int perm32(int rho) { const int n = rho >> 4, i = rho & 15; return 8 * (i >> 2) + 4 * n + (i & 3); }

struct Unit { int pm, pn; };
struct Gemm { const bf16_t* A; const bf16_t* Bt; int M, N, K; };

struct StaticOrder {
    int nM, nN, nwg, G, c;
    __host__ __device__ void init(int M, int N, int G_, int c_) { nM = M / BM; nN = N / BM; nwg = nM * nN; G = G_; c = c_; }
    __host__ __device__ bool next(int i, Unit& u) const {
        const long L = (long)i * G + c; if (L >= nwg) return false;
        int wgid = (int)L; { const int q = nwg / NXCD, r = nwg % NXCD, xcd = wgid % NXCD, off = wgid / NXCD; wgid = (xcd < r ? xcd * (q + 1) : r * (q + 1) + (xcd - r) * q) + off; }
        const int nig = WGM * nN, gid = wgid / nig, fm = gid * WGM, gsz = (nM - fm) < WGM ? (nM - fm) : WGM;
        u.pm = fm + ((wgid % nig) % gsz); u.pn = (wgid % nig) / gsz; return true;
    }
    __device__ __forceinline__ void a_ready(const Unit&) const {}
    __device__ __forceinline__ void done(const Unit&) const {}
};
__device__ __forceinline__ unsigned cvt_pk_bf16(float lo, float hi) { unsigned r; asm volatile("v_cvt_pk_bf16_f32 %0, %1, %2" : "=v"(r) : "v"(lo), "v"(hi)); return r; }
typedef int v8i_t __attribute__((ext_vector_type(8)));
typedef int v4i_t __attribute__((ext_vector_type(4)));
__device__ __forceinline__ f32x4 mfma8(bf16x8 b0, bf16x8 b1, bf16x8 a0, bf16x8 a1, f32x4 c) {
    const v8i_t B = __builtin_shufflevector(__builtin_bit_cast(v4i_t, b0), __builtin_bit_cast(v4i_t, b1), 0, 1, 2, 3, 4, 5, 6, 7);
    const v8i_t A = __builtin_shufflevector(__builtin_bit_cast(v4i_t, a0), __builtin_bit_cast(v4i_t, a1), 0, 1, 2, 3, 4, 5, 6, 7);
#if defined(MFMA8_BUILTIN)
    return __builtin_amdgcn_mfma_scale_f32_16x16x128_f8f6f4(B, A, c, 0, 0, 0, 0x7F7F7F7F, 0, 0x7F7F7F7F);
#else
    const int one = 0x7F7F7F7F;
    asm volatile("s_nop 1\n\tv_mfma_scale_f32_16x16x128_f8f6f4 %0, %1, %2, %0, %3, %3 op_sel_hi:[0,0,0]" : "+v"(c) : "v"(B), "v"(A), "v"(one));
    return c;
#endif
}
constexpr int IDTAB_OFF = 157696;
template <class Epi, class Sched, bool ALIGN_EPI = false, bool SP2 = false, bool FP8 = false, bool GATHER = false>
__device__ __forceinline__ void gemm_phase(PG8_LAS unsigned char* lds, const Gemm g, const Sched& S, const Epi& E, int tid_in) {
    int tid_l = tid_in; asm volatile("" : "+v"(tid_l));
    const int tid = tid_l, wid = __builtin_amdgcn_readfirstlane(tid >> 6), lane = tid & 63, wr = wid >> 2, wc = wid & 3, fr = lane & 15, fq = lane >> 4;
    const int K = g.K, nt = K / BK;
    unsigned voffA[2], voffB[2], voffB1[2];
#pragma unroll
    for (int i = 0; i < 2; ++i) { int R, C; stage_rc(tid * 16 + i * 8192, R, C); const int Rb = Epi::PERM ? ((R & ~31) + perm32(R & 31)) : R;
        voffA[i] = (unsigned)(R * K + C) * 2u; voffB[i] = (unsigned)(Rb * K + C) * 2u; voffB1[i] = 0u;
        if constexpr (Epi::PERM16) { const int rho = R & 31, ii = rho & 15, R16 = 64 * (R >> 5) + 16 * (ii >> 2) + 4 * (rho >> 4) + (ii & 3); voffB[i] = (unsigned)(R16 * K + C) * 2u; voffB1[i] = (unsigned)((R16 + 8) * K + C) * 2u; } }
    static_assert(!GATHER || SP2, "GATHER is implemented for the SP2 loop only");
    unsigned gA[2], gN[2];
    int gR0, gC0; stage_rc(tid * 16, gR0, gC0);
    const unsigned gc2 = (unsigned)gC0 * 2u, gpitch = (unsigned)K * 2u;
#define PG8_GROWS(dst, U) do { if constexpr (GATHER) { int _t = tid; asm volatile("" : "+v"(_t)); int _R, _C; stage_rc(_t * 16, _R, _C);   \
        _Pragma("unroll") for (int _h = 0; _h < 2; ++_h) dst[_h] = (unsigned)S.arow(U, _h * HALF + _R) | ((unsigned)S.arow(U, _h * HALF + _R + 64) << 16); } } while (0)
#define PG8_GCOPY(dst, src) do { if constexpr (GATHER) { dst[0] = src[0]; dst[1] = src[1]; } } while (0)
    const size_t kstep = (size_t)(BK * 2);
    const size_t hstep = (size_t)HALF * K * 2;
    const size_t tstep = 2 * hstep;
    const unsigned ldsw = (unsigned)wid * 1024u;
    const int aoff = lds_byte(wr * 64 + fr, fq * 8), boff = lds_byte(wc * 32 + fr, fq * 8);
#define PG8_SA(b, h) (((b) * 2 + (h)) * HTB)
#define PG8_SB(b, h) ((4 + (b) * 2 + (h)) * HTB)
#define PG8_STAGE(bufoff, gbase, voff) do { _Pragma("unroll") for (int _i = 0; _i < 2; ++_i) \
        __builtin_amdgcn_global_load_lds((const unsigned*)((const char*)(gbase) + (voff)[_i]), (PG8_LAS unsigned*)(lds + (bufoff) + ldsw + _i * 8192), 16, 0, 0); } while (0)
#define PG8_STAGE_A(bufoff, gbase, half, usenext) do { if constexpr (GATHER) { const unsigned _pk = (usenext) ? gN[half] : gA[half]; unsigned _v[2]; _v[0] = (_pk & 0xffffu) * gpitch + gc2; _v[1] = (_pk >> 16) * gpitch + gc2; PG8_STAGE(bufoff, gbase, _v); } \
        else { PG8_STAGE(bufoff, (gbase) + ((half) ? hstep : 0), voffA); } } while (0)
#define PG8_STAGE_B1(bufoff, gbase) do { if constexpr (Epi::PERM16) { PG8_STAGE(bufoff, gbase, voffB1); } else { PG8_STAGE(bufoff, (gbase) + hstep, voffB); } } while (0)
#define PG8_LDA(dst, b, h) do { _Pragma("unroll") for (int m = 0; m < 4; ++m) _Pragma("unroll") for (int k = 0; k < 2; ++k) dst[m][k] = *(const PG8_LAS bf16x8*)(lds + PG8_SA(b, h) + aoff + m * 2048 + k * 1024); } while (0)
#define PG8_LDB(dst, b, h) do { _Pragma("unroll") for (int n = 0; n < 2; ++n) _Pragma("unroll") for (int k = 0; k < 2; ++k) dst[n][k] = *(const PG8_LAS bf16x8*)(lds + PG8_SB(b, h) + boff + n * 2048 + k * 1024); } while (0)
#define PG8_MMA(ai, bj, At, Bt) do { __builtin_amdgcn_s_setprio(1); _Pragma("unroll") for (int m = 0; m < 4; ++m) _Pragma("unroll") for (int n = 0; n < 2; ++n) { \
        if constexpr (FP8) { acc[ai][bj][m][n] = mfma8(Bt[n][0], Bt[n][1], At[m][0], At[m][1], acc[ai][bj][m][n]); } \
        else { _Pragma("unroll") for (int k = 0; k < 2; ++k) acc[ai][bj][m][n] = __builtin_amdgcn_mfma_f32_16x16x32_bf16(Bt[n][k], At[m][k], acc[ai][bj][m][n], 0, 0, 0); } } __builtin_amdgcn_s_setprio(0); } while (0)
#define PG8_WAIT_V(n) asm volatile("s_waitcnt vmcnt(" #n ")" ::: "memory")
#define PG8_WAIT_VF do { if (fst) asm volatile("s_waitcnt vmcnt(%0)" :: "n"(8 + Epi::NVM) : "memory"); else asm volatile("s_waitcnt vmcnt(8)" ::: "memory"); } while (0)
#define PG8_WAIT_L(n) asm volatile("s_waitcnt lgkmcnt(" #n ")" ::: "memory")
#define PG8_BAR __builtin_amdgcn_s_barrier()
#define PG8_SCHED __builtin_amdgcn_sched_barrier(0)
    Unit cur, nxt; int ui = 0;
    if (!S.next(0, cur)) return;
    f32x4 acc[2][2][4][2];
#pragma unroll
    for (int a = 0; a < 2; ++a)
#pragma unroll
        for (int b = 0; b < 2; ++b)
#pragma unroll
            for (int m = 0; m < 4; ++m)
#pragma unroll
                for (int n = 0; n < 2; ++n) acc[a][b][m][n] = (f32x4){0.f, 0.f, 0.f, 0.f};
    bf16x8 At[4][2], B0[2][2], B1[2][2];
    const char* cA = GATHER ? (const char*)g.A : (const char*)g.A + (size_t)cur.pm * tstep; const char* cB = (const char*)g.Bt + (size_t)cur.pn * tstep;
    S.a_ready(cur);
    if constexpr (GATHER) { PG8_GROWS(gA, cur);
        Unit u1; if (S.next(1, u1)) { PG8_GROWS(gN, u1); } else { PG8_GCOPY(gN, gA); } }
    if constexpr (SP2) {
        PG8_STAGE(PG8_SB(0, 0), cB, voffB); PG8_STAGE_B1(PG8_SB(0, 1), cB); PG8_STAGE_A(PG8_SA(0, 0), cA, 0, false); PG8_STAGE_A(PG8_SA(0, 1), cA, 1, false);
        if (wr == 1) PG8_BAR;
        PG8_WAIT_V(2); PG8_BAR;
        PG8_STAGE(PG8_SB(1, 0), cB + kstep, voffB); PG8_STAGE_A(PG8_SA(1, 0), cA + kstep, 0, false); PG8_STAGE_B1(PG8_SB(1, 1), cB + kstep);
        PG8_WAIT_V(6); PG8_BAR;
    } else {
        PG8_STAGE(PG8_SB(0, 0), cB, voffB); PG8_STAGE(PG8_SA(0, 0), cA, voffA); PG8_STAGE_B1(PG8_SB(0, 1), cB); PG8_STAGE(PG8_SA(0, 1), cA + hstep, voffA);
        if (wr == 1) PG8_BAR;
        PG8_WAIT_V(4); PG8_BAR;
        PG8_STAGE(PG8_SB(1, 0), cB + kstep, voffB); PG8_STAGE(PG8_SA(1, 0), cA + kstep, voffA); PG8_STAGE_B1(PG8_SB(1, 1), cB + kstep);
        PG8_WAIT_V(6); PG8_BAR;
    }
    for (;;) {
        const bool has_next = S.next(ui + 1, nxt);
        Unit nx2; bool has2 = false;
        if constexpr (GATHER) has2 = has_next && S.next(ui + 2, nx2);
        const char* nA = (has_next && !GATHER) ? (const char*)g.A + (size_t)nxt.pm * tstep : cA; const char* nB = has_next ? (const char*)g.Bt + (size_t)nxt.pn * tstep : cB;
        PG8_LAS unsigned char* const pre = lds + STAGE_BYTES + wid * 2048;
#pragma unroll 1
        for (int t = 0; t < nt; t += 2) {
            const bool last = (t == nt - 2);
            const bool fst = SP2 && Epi::NVM > 0 && t == 0 && ui > 0;
            if (last) { E.prefetch(pre, cur, wr, wc, fr, fq);
                if constexpr (GATHER) { if (has2 && wid < 4) __builtin_amdgcn_global_load_lds((const unsigned*)S.arow_ptr(nx2, wid * 64 + lane), (PG8_LAS unsigned*)(lds + IDTAB_OFF + wid * 256), 4, 0, 0); } }
            const char* a1 = cA + (size_t)(t + 1) * kstep;
            const char* a2 = last ? nA : cA + (size_t)(t + 2) * kstep; const char* b2 = last ? nB : cB + (size_t)(t + 2) * kstep;
            const char* a3 = a2 + kstep; const char* b3 = b2 + kstep;
            if (last && has_next) S.a_ready(nxt);
            if constexpr (SP2) {
            PG8_LDB(B0, 0, 0); PG8_LDB(B1, 0, 1); PG8_SCHED; PG8_LDA(At, 0, 0); if (!fst) { PG8_STAGE_A(PG8_SA(1, 1), a1, 1, false); }
            PG8_WAIT_VF; PG8_WAIT_L(0); PG8_BAR; PG8_MMA(0, 0, At, B0); PG8_MMA(0, 1, At, B1); PG8_BAR; PG8_SCHED;
            PG8_LDA(At, 0, 1); PG8_STAGE(PG8_SB(0, 0), b2, voffB); PG8_STAGE_B1(PG8_SB(0, 1), b2); PG8_STAGE_A(PG8_SA(0, 0), a2, 0, last);
            PG8_WAIT_VF; PG8_WAIT_L(0); PG8_BAR; PG8_MMA(1, 0, At, B0); PG8_MMA(1, 1, At, B1); PG8_BAR; PG8_SCHED;
            PG8_LDB(B0, 1, 0); PG8_LDB(B1, 1, 1); PG8_SCHED; PG8_LDA(At, 1, 0); PG8_STAGE_A(PG8_SA(0, 1), a2, 1, last);
            PG8_WAIT_VF; PG8_WAIT_L(0); PG8_BAR; PG8_MMA(0, 0, At, B0); PG8_MMA(0, 1, At, B1); PG8_BAR; PG8_SCHED;
            PG8_LDA(At, 1, 1); PG8_STAGE(PG8_SB(1, 0), b3, voffB); PG8_STAGE_B1(PG8_SB(1, 1), b3); PG8_STAGE_A(PG8_SA(1, 0), a3, 0, last);
            PG8_WAIT_V(8); PG8_WAIT_L(0); PG8_BAR; PG8_MMA(1, 0, At, B0); PG8_MMA(1, 1, At, B1); PG8_BAR; PG8_SCHED;
            } else {
            PG8_LDB(B0, 0, 0); PG8_SCHED; PG8_LDA(At, 0, 0); PG8_STAGE(PG8_SA(1, 1), a1 + hstep, voffA);
            PG8_WAIT_L(8); PG8_BAR; PG8_WAIT_L(0); PG8_MMA(0, 0, At, B0); PG8_BAR; PG8_SCHED;
            PG8_LDB(B1, 0, 1); PG8_STAGE(PG8_SB(0, 0), b2, voffB);
            PG8_BAR; PG8_WAIT_L(0); PG8_MMA(0, 1, At, B1); PG8_BAR;
            PG8_LDA(At, 0, 1); PG8_STAGE(PG8_SA(0, 0), a2, voffA);
            PG8_BAR; PG8_WAIT_L(0); PG8_MMA(1, 0, At, B0); PG8_BAR; PG8_SCHED;
            PG8_STAGE_B1(PG8_SB(0, 1), b2);
            PG8_WAIT_V(6); PG8_BAR; PG8_MMA(1, 1, At, B1); PG8_BAR;
            PG8_LDB(B0, 1, 0); PG8_SCHED; PG8_LDA(At, 1, 0); PG8_STAGE(PG8_SA(0, 1), a2 + hstep, voffA);
            PG8_WAIT_L(8); PG8_BAR; PG8_WAIT_L(0); PG8_MMA(0, 0, At, B0); PG8_BAR; PG8_SCHED;
            PG8_LDB(B1, 1, 1); PG8_STAGE(PG8_SB(1, 0), b3, voffB);
            PG8_BAR; PG8_WAIT_L(0); PG8_MMA(0, 1, At, B1); PG8_BAR;
            PG8_LDA(At, 1, 1); PG8_STAGE(PG8_SA(1, 0), a3, voffA);
            PG8_BAR; PG8_WAIT_L(0); PG8_MMA(1, 0, At, B0); PG8_BAR; PG8_SCHED;
            PG8_STAGE_B1(PG8_SB(1, 1), b3);
            PG8_WAIT_V(6); PG8_BAR; PG8_MMA(1, 1, At, B1); PG8_BAR;
            }
        }
        if constexpr (SP2 && Epi::NVM > 0) { if (has_next) { PG8_STAGE_A(PG8_SA(1, 1), nA + kstep, 1, true); } }
        if constexpr (FP8) {
#pragma unroll
            for (int a = 0; a < 2; ++a)
#pragma unroll
                for (int b = 0; b < 2; ++b) {
                    if (a == 0 && b == 0) asm volatile("s_nop 15\n\ts_nop 15\n\ts_nop 15\n\ts_nop 15\n\ts_nop 7" : "+v"(acc[a][b][0][0]), "+v"(acc[a][b][0][1]), "+v"(acc[a][b][1][0]), "+v"(acc[a][b][1][1]), "+v"(acc[a][b][2][0]), "+v"(acc[a][b][2][1]), "+v"(acc[a][b][3][0]), "+v"(acc[a][b][3][1]));
                    else asm volatile("" : "+v"(acc[a][b][0][0]), "+v"(acc[a][b][0][1]), "+v"(acc[a][b][1][0]), "+v"(acc[a][b][1][1]), "+v"(acc[a][b][2][0]), "+v"(acc[a][b][2][1]), "+v"(acc[a][b][3][0]), "+v"(acc[a][b][3][1])); }
        }
        int tkr[2][2];
        if constexpr (GATHER) { if (has2) { int _t = tid; asm volatile("" : "+v"(_t)); int _R, _C; stage_rc(_t * 16, _R, _C); const PG8_LAS int* idt = (const PG8_LAS int*)(lds + IDTAB_OFF);
#pragma unroll
            for (int _h = 0; _h < 2; ++_h) { tkr[_h][0] = idt[_h * HALF + _R]; tkr[_h][1] = idt[_h * HALF + _R + 64]; } } }
        if constexpr (ALIGN_EPI) { if (wr == 0) PG8_BAR; }
        if constexpr (!Epi::AFTER_DRAIN) { E(acc, cur, wr, wc, fr, fq, pre); S.done(cur); }
        if (!has_next) break;
#pragma unroll
        for (int a = 0; a < 2; ++a)
#pragma unroll
            for (int b = 0; b < 2; ++b)
#pragma unroll
                for (int m = 0; m < 4; ++m)
#pragma unroll
                    for (int n = 0; n < 2; ++n) acc[a][b][m][n] = (f32x4){0.f, 0.f, 0.f, 0.f};
        cur = nxt; cA = nA; cB = nB; ++ui;
        if constexpr (GATHER) { PG8_GCOPY(gA, gN); if (has2) { gN[0] = (unsigned)tkr[0][0] | ((unsigned)tkr[0][1] << 16); gN[1] = (unsigned)tkr[1][0] | ((unsigned)tkr[1][1] << 16); } }
        if constexpr (ALIGN_EPI) { if (wr == 1) PG8_BAR; }
    }
    PG8_WAIT_V(0);
    if constexpr (!ALIGN_EPI) { if (wr == 0) PG8_BAR; }
    PG8_BAR;
    if constexpr (Epi::AFTER_DRAIN) { E.fused(acc, cur, wr, wc, fr, fq, lds, wid, lane); S.done(cur); }
#undef PG8_SA
#undef PG8_STAGE_A
#undef PG8_STAGE_B1
#undef PG8_GROWS
#undef PG8_GCOPY
#undef PG8_SB
#undef PG8_STAGE
#undef PG8_LDA
#undef PG8_LDB
#undef PG8_MMA
#undef PG8_WAIT_V
#undef PG8_WAIT_L
#undef PG8_WAIT_VF
#undef PG8_BAR
#undef PG8_SCHED
}
}
constexpr int D = 1024, NB = 4, SEQ = 8192, TL = NB * SEQ, LC = 256, TCX = NB * LC, TT = TL + TCX;
constexpr int DEPTH = 4, NH = 4, DK = 128, DV = 256, QKW = 512, RWD = 1024, CWD = 512, MIXW = 1536, INW = 4608;
constexpr int NE = 32, TOPK = 4, DFF = 1024, NCH = 66;
constexpr int RMAX = TT * TOPK + NE * 256;
constexpr float EPS = 1e-6f;
constexpr int NWAVES = 8;

constexpr size_t MiB = 1u << 20;
constexpr size_t WS_CTL = 0, CTL_ZERO_BYTES = 1 * MiB;
constexpr size_t WS_MODV = 1 * MiB;
constexpr size_t WS_ROPE = 2 * MiB;
constexpr size_t WS_G1H = 2 * MiB + 64 * 1024;
constexpr size_t WS_BUPH = 2 * MiB + 256 * 1024, WS_BDNH = 2 * MiB + 768 * 1024;
constexpr size_t WS_RWHL = 3 * MiB;
constexpr size_t WS_WINT = 4 * MiB;
constexpr size_t WS_WOUTT = 40 * MiB;
constexpr size_t WS_WUPT = 64 * MiB;
constexpr size_t WS_WDNT = 576 * MiB;
constexpr size_t WS_X = 832 * MiB;
constexpr size_t WS_HB = 964 * MiB;
constexpr size_t WS_QB = 1032 * MiB, WS_KB = 1066 * MiB, WS_VB = 1100 * MiB, WS_GB = 1168 * MiB, WS_CBB = 1236 * MiB, WS_CCB = 1270 * MiB, WS_CXB = 1304 * MiB;
constexpr size_t WS_KVF = 1338 * MiB, WS_KVB = 1404 * MiB;
constexpr size_t WS_MIX = 1470 * MiB;
constexpr size_t WS_ASG = 1570 * MiB;
constexpr size_t WS_XG = 1576 * MiB, WS_ACT = 1856 * MiB, WS_YB = 2136 * MiB;
constexpr size_t WS_TLIST = WS_XG;
constexpr size_t WS_HB8 = WS_XG + 144 * MiB;
constexpr size_t WS_XB = 2416 * MiB;
constexpr size_t WS_SF = 2548 * MiB, WS_SB = 2614 * MiB, WS_END = 2680 * MiB;
static_assert((size_t)RMAX * 1024 * 2 <= 280 * MiB && (size_t)TT * 1536 * 2 <= 100 * MiB && (size_t)16 * 66 * 32768 * 2 <= 66 * MiB, "ws map");
constexpr int CW_ERR = 1, CW_BAR = 4096, CW_GCNT = 16384;

constexpr int PH_LDS = 155648;
constexpr int MISC_OFF = PH_LDS, LDS_BYTES = PH_LDS + 2048 + 1024; static_assert(pg8::IDTAB_OFF == MISC_OFF + 2048, "gather id table");
constexpr int RPITCH = 272;

#define GAS __attribute__((address_space(1)))
#define LAS __attribute__((address_space(3)))
typedef unsigned short bf16;
typedef unsigned v4u __attribute__((ext_vector_type(4)));
typedef unsigned v2u __attribute__((ext_vector_type(2)));
typedef float f32x4 __attribute__((ext_vector_type(4)));
typedef short bf16x8 __attribute__((ext_vector_type(8)));
typedef short s16x4 __attribute__((ext_vector_type(4)));
#define LDS_WAIT() asm volatile("s_waitcnt lgkmcnt(0)" ::: "memory")
#define VM_WAIT() asm volatile("s_waitcnt vmcnt(0)" ::: "memory")
__device__ __forceinline__ unsigned f2bf(float f) { unsigned u = __builtin_bit_cast(unsigned, f); return (u + 0x7fffu + ((u >> 16) & 1u)) >> 16; }
typedef float f32x2_t __attribute__((ext_vector_type(2)));
typedef __bf16 bf16x2_t __attribute__((ext_vector_type(2)));
__device__ __forceinline__ unsigned pk2(float lo, float hi) { const f32x2_t v = {lo, hi}; return __builtin_bit_cast(unsigned, __builtin_convertvector(v, bf16x2_t)); }
__device__ __forceinline__ float bflo(unsigned w) { return __builtin_bit_cast(float, w << 16); }
__device__ __forceinline__ float bfhi(unsigned w) { return __builtin_bit_cast(float, w & 0xffff0000u); }
__device__ __forceinline__ v2u pk8_fp8(const float (&f)[8]) {
    int w0 = __builtin_amdgcn_cvt_pk_fp8_f32(f[0], f[1], 0, false); w0 = __builtin_amdgcn_cvt_pk_fp8_f32(f[2], f[3], w0, true);
    int w1 = __builtin_amdgcn_cvt_pk_fp8_f32(f[4], f[5], 0, false); w1 = __builtin_amdgcn_cvt_pk_fp8_f32(f[6], f[7], w1, true);
    v2u o; o.x = (unsigned)w0; o.y = (unsigned)w1; return o;
}
__device__ __forceinline__ float bf2f(bf16 b) { return __builtin_bit_cast(float, ((unsigned)b) << 16); }
__device__ __forceinline__ float logsig(float x) { return -log1pf(expf(-x)); }
__device__ __forceinline__ float fexp(float x) { return __builtin_amdgcn_exp2f(x * 1.44269504088896f); }
__device__ __forceinline__ float fsigm(float x) { return __builtin_amdgcn_rcpf(1.f + fexp(-x)); }
__device__ __forceinline__ int shx_i(int v, int o, int lane) { return __builtin_amdgcn_ds_bpermute((lane ^ o) << 2, v); }
__device__ __forceinline__ float shx_f(float v, int o, int lane) { return __builtin_bit_cast(float, __builtin_amdgcn_ds_bpermute((lane ^ o) << 2, __builtin_bit_cast(int, v))); }
__device__ __forceinline__ int shl_i(int v, int src) { return __builtin_amdgcn_ds_bpermute(src << 2, v); }
__device__ __forceinline__ float shl_f(float v, int src) { return __builtin_bit_cast(float, __builtin_amdgcn_ds_bpermute(src << 2, __builtin_bit_cast(int, v))); }
__device__ __forceinline__ float wave_sum(float v, int lane) {
#pragma unroll
    for (int o = 1; o < 64; o <<= 1) v += shx_f(v, o, lane);
    return v;
}

#define XB_TMO      128
#define XB_XCNT(j)  (256  + 64 * (j))
#define XB_XSUB(j)  (1280 + 64 * (j))
#define XB_XGEN(j)  (2304 + 64 * (j))
#define XB_TOP      3328
#define XB_TOPGEN   3392
#define XCD_BAR_WORDS 3456
#define XB_SPIN_CAP (1u << 18)

__device__ __forceinline__ unsigned xb_ld(unsigned* p)              { return __hip_atomic_load(p, __ATOMIC_RELAXED, __HIP_MEMORY_SCOPE_AGENT); }
__device__ __forceinline__ unsigned xb_add(unsigned* p, unsigned v) { return __hip_atomic_fetch_add(p, v, __ATOMIC_RELAXED, __HIP_MEMORY_SCOPE_AGENT); }
__device__ __forceinline__ unsigned xb_xcc_id() { return (unsigned)__builtin_amdgcn_s_getreg((3 << 11) | 20) & 0xFu; }
#define XB_SPIN(cond, bar) do { unsigned _sp = 0; while (cond) { __builtin_amdgcn_s_sleep(1); \
    if ((++_sp & 255u) == 0u) { if (xb_ld(&(bar)[XB_TMO])) break; if (_sp > XB_SPIN_CAP) { atomicAdd(&(bar)[XB_TMO], 1u); break; } } } } while (0)

struct XcdBarrier {
    unsigned* bar; unsigned x;
    volatile LAS unsigned* st;
};

__device__ __forceinline__ XcdBarrier xcd_barrier_post(unsigned* bar, volatile LAS unsigned* st) {
    XcdBarrier b; b.bar = bar; b.x = xb_xcc_id(); b.st = st;
    if (threadIdx.x == 0) (void)xb_add(&bar[XB_XCNT(b.x)], 1u);
    return b;
}
__device__ __forceinline__ void xcd_barrier_complete(unsigned* bar, unsigned x, unsigned& nloc, unsigned& nx) {
    const unsigned G = gridDim.x * gridDim.y * gridDim.z;
    unsigned sum, cnt, mine, sp = 0u;
    for (;;) {
        sum = 0u; cnt = 0u; mine = 0u;
#pragma unroll
        for (unsigned j = 0; j < 16; ++j) { const unsigned c = xb_ld(&bar[XB_XCNT(j)]); sum += c; cnt += (c > 0u) ? 1u : 0u; mine = (j == x) ? c : mine; }
        if (sum == G) break;
        __builtin_amdgcn_s_sleep(1);
        if ((++sp & 255u) == 0u) { if (xb_ld(&bar[XB_TMO])) break; if (sp > XB_SPIN_CAP) { atomicAdd(&bar[XB_TMO], 1u); break; } }
    }
    nloc = mine > 0u ? mine : 1u; nx = cnt > 0u ? cnt : 1u;
}

__device__ __forceinline__ void xcd_barrier(const XcdBarrier& b) {
    asm volatile("s_waitcnt vmcnt(0)" ::: "memory");
    __syncthreads();
    if (threadIdx.x == 0) {
        unsigned* bar = b.bar;
        __builtin_amdgcn_s_waitcnt(0);
        unsigned nloc = b.st[0], nx = b.st[1];
        if (nloc == 0u) { xcd_barrier_complete(bar, b.x, nloc, nx); b.st[0] = nloc; b.st[1] = nx; }
        const unsigned old = xb_add(&bar[XB_XSUB(b.x)], 1u);
        const unsigned gen = old / nloc;
        if (old + 1u == (gen + 1u) * nloc) {
            __builtin_amdgcn_fence(__ATOMIC_RELEASE, "agent");
            asm volatile("s_waitcnt vmcnt(0)" ::: "memory");
            const unsigned og = xb_add(&bar[XB_TOP], 1u);
            const unsigned tg = og / nx;
            if (og + 1u == (tg + 1u) * nx) xb_add(&bar[XB_TOPGEN], 1u);
            else XB_SPIN(xb_ld(&bar[XB_TOPGEN]) == tg, bar);
            __builtin_amdgcn_fence(__ATOMIC_ACQUIRE, "agent");
            xb_add(&bar[XB_XGEN(b.x)], 1u);
            asm volatile("s_waitcnt vmcnt(0)" ::: "memory");
        } else {
            XB_SPIN(xb_ld(&bar[XB_XGEN(b.x)]) == gen, bar);
            __builtin_amdgcn_fence(__ATOMIC_ACQUIRE, "agent");
            asm volatile("s_waitcnt vmcnt(0)" ::: "memory");
        }
    }
    __syncthreads();
}

struct Args { const float* in[20]; float* out; unsigned char* ws; int ph_lo, ph_hi, probe, pad; };
#define CAS __attribute__((address_space(4)))
struct Frame {
    LAS unsigned char* lds;
    unsigned* ctl;
    int tid, lane, wave, G, bid;
    const CAS Args* ka; float* out; unsigned char* ws;
};
#define MKFRAME(F) Frame F; { int t_; asm volatile("v_mbcnt_lo_u32_b32 %0, -1, 0\n\tv_mbcnt_hi_u32_b32 %0, -1, %0\n\tv_lshl_or_b32 %0, %1, 6, %0" : "=&v"(t_) : "s"(wave0));     \
    F.tid = t_; F.lane = t_ & 63; F.wave = __builtin_amdgcn_readfirstlane(t_ >> 6); \
    const CAS Args* ka_ = (const CAS Args*)__builtin_amdgcn_kernarg_segment_ptr(); asm volatile("" : "+s"(ka_)); F.ka = ka_; F.ws = ka_->ws; F.out = ka_->out; F.ctl = (unsigned*)ka_->ws; \
    F.lds = (LAS unsigned char*)lds; F.G = gridDim.x; F.bid = blockIdx.x; }
#define IN_(i) (F.ka->in[i])
#define WSP(T, off) ((T*)(F.ws + (off)))

__device__ __forceinline__ void p0_mod(Frame& F) {
    LAS float* sv = (LAS float*)(F.lds);
    LAS float* red = (LAS float*)(F.lds + 20480);
    float* MODV = WSP(float, WS_MODV);
    bool filled = false;
    for (int s = F.bid; s < DEPTH * 48; s += F.G) {
        if (!filled) {
            for (int i = F.tid; i < 5 * 1024; i += 512) { const int si = i >> 10, k = i & 1023; const float c = si < 4 ? IN_(1)[si * 1024 + k] : IN_(3)[k]; sv[i] = c / (1.f + expf(-c)); }
            __syncthreads(); filled = true;
        }
        const int l = s / 48, col0 = (s % 48) * 128, kg = F.tid >> 7, j = F.tid & 127;
        const float* w = IN_(4) + (size_t)l * 1024 * 6144 + col0 + j;
        float a0 = 0.f, a1 = 0.f, a2 = 0.f, a3 = 0.f, a4 = 0.f;
#pragma unroll 8
        for (int k = kg * 256; k < kg * 256 + 256; ++k) { const float wv = w[(size_t)k * 6144]; a0 += sv[k] * wv; a1 += sv[1024 + k] * wv; a2 += sv[2048 + k] * wv; a3 += sv[3072 + k] * wv; a4 += sv[4096 + k] * wv; }
        red[(kg * 5 + 0) * 128 + j] = a0; red[(kg * 5 + 1) * 128 + j] = a1; red[(kg * 5 + 2) * 128 + j] = a2; red[(kg * 5 + 3) * 128 + j] = a3; red[(kg * 5 + 4) * 128 + j] = a4;
        __syncthreads();
        if (F.tid < 128) {
            const float bias = IN_(5)[l * 6144 + col0 + j];
#pragma unroll
            for (int s5 = 0; s5 < 5; ++s5) { const float t = ((red[(0 * 5 + s5) * 128 + j] + red[(1 * 5 + s5) * 128 + j]) + red[(2 * 5 + s5) * 128 + j]) + red[(3 * 5 + s5) * 128 + j];
                MODV[(size_t)(l * 5 + s5) * 6144 + col0 + j] = t + bias;
                if (col0 >= 2048 && col0 < 3072) WSP(bf16, WS_G1H)[(size_t)(l * 5 + s5) * 1024 + col0 - 2048 + j] = (bf16)f2bf((t + bias) * 0.03125f); }
        }
        __syncthreads();
    }
}
template <int MAP> __device__ __forceinline__ int rowmap(int n) {
    if (MAP == 1) { if (n < 1024) return (n & ~63) | ((n & 31) << 1) | ((n >> 5) & 1);
        if (n >= 3584) { const int j = (n - 3584) & 511; return 3584 + ((j >> 7) << 8) + (n >= 4096 ? 128 : 0) + (j & 127); }
        return n; }
    if (MAP == 2) return n < 1024 ? (((n >> 7) << 8) | (n & 127)) : ((((n - 1024) >> 7) << 8) | 128 | ((n - 1024) & 127));
    return n;
}
constexpr int I_IN = 16 * 72, I_OUT = 24 * 16, I_UP = 32 * 16 * 32, I_DN = 32 * 16 * 16, I_L = I_IN + I_OUT + I_UP + I_DN;
constexpr int CW_QCONV = 12288;
constexpr int CVT_BATCH = 4;
constexpr int CVT_P = 65;
struct CvtItem { const float* W; unsigned char* WT; int N, K, k0, n0, kind; };
__device__ __forceinline__ void cvt_desc(Frame& F, int l, int r, CvtItem& d) {
    if (r < I_IN) { d.W = IN_(8) + (size_t)l * 1024 * INW; d.K = 1024; d.N = INW; d.WT = (unsigned char*)(WSP(bf16, WS_WINT) + (size_t)l * INW * 1024); d.kind = 0; d.k0 = 64 * (r / 72); d.n0 = 64 * (r % 72); return; } r -= I_IN;
    if (r < I_OUT) { d.W = IN_(12) + (size_t)l * MIXW * 1024; d.K = MIXW; d.N = 1024; d.WT = WSP(unsigned char, WS_WOUTT) + (size_t)l * 1024 * MIXW; d.kind = 1; d.k0 = 64 * (r >> 4); d.n0 = 64 * (r & 15); return; } r -= I_OUT;
    if (r < I_UP) { const int e = r >> 9, it = r & 511; d.W = IN_(15) + (size_t)(l * NE + e) * 1024 * 2048; d.K = 1024; d.N = 2048; d.WT = WSP(unsigned char, WS_WUPT) + (size_t)(l * NE + e) * 2048 * 1024; d.kind = 2; d.k0 = 64 * (it >> 5); d.n0 = 64 * (it & 31); return; } r -= I_UP;
    { const int e = r >> 8, it = r & 255; d.W = IN_(17) + (size_t)(l * NE + e) * 1024 * 1024; d.K = 1024; d.N = 1024; d.WT = WSP(unsigned char, WS_WDNT) + (size_t)(l * NE + e) * 1024 * 1024; d.kind = 1; d.k0 = 64 * (it >> 4); d.n0 = 64 * (it & 15); }
}
__device__ __forceinline__ void convert_item(Frame& F, int l, int r) {
    LAS float* scr = (LAS float*)(F.lds + F.wave * 16896);
    CvtItem d; cvt_desc(F, l, r, d);
    const int lane = F.lane, r2 = lane >> 4, n4 = (lane & 15) * 4;
    f32x4 wv[16];
#pragma unroll
    for (int i = 0; i < 16; ++i) wv[i] = *(const f32x4*)(d.W + (size_t)(d.k0 + 4 * i + r2) * d.N + d.n0 + n4);
    const float sc = d.kind == 0 ? (d.n0 < 512 ? 0.08838834764831845f : 1.f) : 32.f;
#pragma unroll
    for (int i = 0; i < 16; ++i) { LAS float* t = scr + (4 * i + r2) * CVT_P + n4; const f32x4 v = wv[i] * sc; t[0] = v[0]; t[1] = v[1]; t[2] = v[2]; t[3] = v[3]; }
    LDS_WAIT(); asm volatile("" ::: "memory");
    const int c = lane & 7;
#pragma unroll
    for (int j = 0; j < 8; ++j) { const int n = (lane >> 3) + 8 * j, nn = d.n0 + n; const LAS float* s = scr + (8 * c) * CVT_P + n;
        if (d.kind == 0) { v4u o; o.x = pk2(s[0 * CVT_P], s[1 * CVT_P]); o.y = pk2(s[2 * CVT_P], s[3 * CVT_P]); o.z = pk2(s[4 * CVT_P], s[5 * CVT_P]); o.w = pk2(s[6 * CVT_P], s[7 * CVT_P]);
            *(v4u*)(d.WT + ((size_t)rowmap<1>(nn) * d.K + d.k0 + 8 * c) * 2) = o; }
        else { float f[8];
#pragma unroll
            for (int q = 0; q < 8; ++q) f[q] = s[q * CVT_P];
            const int row = d.kind == 2 ? rowmap<2>(nn) : nn;
            *(v2u*)(d.WT + (size_t)row * d.K + d.k0 + 8 * c) = pk8_fp8(f); } }
    LDS_WAIT(); asm volatile("" ::: "memory");
}
constexpr int I_A = I_IN + I_OUT, I_B = I_UP + I_DN;
__device__ __forceinline__ void convert_fill(Frame& F, int l, int q, int batches) {
    unsigned* head = F.ctl + CW_QCONV + (q * 4 + l) * 64;
    LAS int* slot = (LAS int*)(F.lds + MISC_OFF + 192);
    const int base = q ? I_A : 0, cnt = q ? I_B : I_A;
    const int bsz = batches < 0 ? (q ? 2 : 1) : CVT_BATCH;
    for (int n = 0; batches < 0 || n < batches; ++n) {
        __syncthreads();
        if (F.tid == 0) *slot = (int)atomicAdd(head, (unsigned)(NWAVES * bsz));
        __syncthreads();
        const int s0 = *slot;
        if (s0 >= cnt) break;
        const int start = s0 + F.wave * bsz;
        for (int k = 0; k < bsz && start + k < cnt; ++k) convert_item(F, l, base + start + k);
    }
}
__device__ __forceinline__ void p0_prologue(Frame& F) {
    p0_mod(F);
    __syncthreads();
    { unsigned* rope = WSP(unsigned, WS_ROPE);
      for (int i = F.bid * 512 + F.tid; i < 128 * 32; i += F.G * 512) { const int p = i >> 5, j = i & 31; const float fr = powf(10000.f, -(float)j / 32.f); const float ang = (float)p * fr; rope[i] = pk2(cosf(ang), sinf(ang)); } }
    { unsigned* bu = WSP(unsigned, WS_BUPH); unsigned* bd = WSP(unsigned, WS_BDNH);
      for (int i = F.bid * 512 + F.tid; i < DEPTH * NE * 1024; i += F.G * 512) bu[i] = pk2(IN_(16)[2 * i], IN_(16)[2 * i + 1]);
      for (int i = F.bid * 512 + F.tid; i < DEPTH * NE * 512; i += F.G * 512) bd[i] = pk2(IN_(18)[2 * i], IN_(18)[2 * i + 1]); }
    { unsigned* rwhl = WSP(unsigned, WS_RWHL);
      for (int idx = F.bid * 512 + F.tid; idx < DEPTH * NE * 512; idx += F.G * 512) { const int l = idx >> 14, rem = idx & 16383, e = rem & 31, kp = rem >> 5;
          const float* rw = IN_(13) + (size_t)l * D * NE; const float w0 = rw[(size_t)(2 * kp) * NE + e], w1 = rw[(size_t)(2 * kp + 1) * NE + e];
          const unsigned hi = pk2(w0, w1); rwhl[((size_t)(l * 2 + 0) * NE + e) * 512 + kp] = hi; rwhl[((size_t)(l * 2 + 1) * NE + e) * 512 + kp] = pk2(w0 - bflo(hi), w1 - bfhi(hi)); } }
    convert_fill(F, 0, 0, -1);
}
__device__ __forceinline__ void moe_offsets(Frame& F, int l) {
    LAS int* toff = (LAS int*)(F.lds + MISC_OFF + 256);
    if (F.tid < 64) {
        const int e = F.tid & 31; const int cnt = (int)__hip_atomic_load(&F.ctl[CW_GCNT + (l * 32 + e) * 64], __ATOMIC_RELAXED, __HIP_MEMORY_SCOPE_AGENT);
        const int tiles = (cnt + 255) >> 8; int incl = tiles;
#pragma unroll
        for (int o = 1; o < 32; o <<= 1) { const int t = shl_i(incl, (F.tid - o) & 63); if (e >= o) incl += t; }
        if (F.tid < 32) { toff[e] = incl - tiles; toff[33 + e] = cnt; if (e == 31) toff[32] = incl; }
    }
    __syncthreads();
    { LAS unsigned char* texp = (LAS unsigned char*)(F.lds + MISC_OFF + 1024);
      const int NT = toff[32];
      for (int rt = F.tid; rt < NT && rt < 1024; rt += 512) { int e = 0;
#pragma unroll
          for (int k = 1; k < NE; ++k) e += (toff[k] <= rt) ? 1 : 0;
          texp[rt] = (unsigned char)e; } }
    __syncthreads();
}

template <bool FINAL> __device__ __forceinline__ void row_phase(Frame& F, int l) {
    const int gw = F.bid * NWAVES + F.wave, NGW = F.G * NWAVES, lane = F.lane;
    constexpr int NR = FINAL ? TL : TT;
    const bf16* XA = WSP(bf16, WS_X); bf16* XB = WSP(bf16, WS_XB); bf16* HB = WSP(bf16, WS_HB); const unsigned char* YB = WSP(unsigned char, WS_YB);
    const int* ae = WSP(int, WS_ASG); const int* ark = WSP(int, WS_ASG + 1 * MiB); const float* aw = WSP(float, WS_ASG + 3 * MiB); const float* MODV = WSP(float, WS_MODV);
    const LAS int* toff = (const LAS int*)(F.lds + MISC_OFF + 256);
    if (!FINAL && l > 0) { convert_fill(F, l, 0, -1); __syncthreads(); }
    if (l > 0) moe_offsets(F, l - 1);
    auto finish = [&](f32x4 (&v)[2][4], int r0, int s) {
#pragma unroll
        for (int q = 0; q < 2; ++q) {
            const int r = r0 + q;
            if (!FINAL) {
#pragma unroll
                for (int j = 0; j < 4; ++j) { v2u o; o.x = pk2(v[q][j].x, v[q][j].y); o.y = pk2(v[q][j].z, v[q][j].w); ((v2u*)(XB + (size_t)r * D))[lane + 64 * j] = o; }
            }
            float ss = 0.f;
#pragma unroll
            for (int j = 0; j < 4; ++j) ss += (v[q][j].x * v[q][j].x + v[q][j].y * v[q][j].y) + (v[q][j].z * v[q][j].z + v[q][j].w * v[q][j].w);
            const float rms = 1.f / sqrtf(wave_sum(ss, lane) * (1.f / D) + EPS);
            if (FINAL) {
#pragma unroll
                for (int j = 0; j < 4; ++j) ((f32x4*)(F.out + (size_t)r * D))[lane + 64 * j] = v[q][j] * rms * ((const f32x4*)IN_(19))[lane + 64 * j];
            } else {
                const float* nm = IN_(6) + (size_t)l * D; const float* sh = MODV + (size_t)(l * 5 + s) * 6144; const float* sc = sh + 1024;
#pragma unroll
                for (int j = 0; j < 4; ++j) { const f32x4 h = v[q][j] * rms * ((const f32x4*)nm)[lane + 64 * j] * (((const f32x4*)sc)[lane + 64 * j] + 1.f) + ((const f32x4*)sh)[lane + 64 * j];
                    v2u o; o.x = pk2(h.x, h.y); o.y = pk2(h.z, h.w); ((v2u*)(HB + (size_t)r * D))[lane + 64 * j] = o; }
            }
        }
    };
    const int step = 2 * NGW;
    if (l == 0) {
        for (int r0 = 2 * gw; r0 < NR; r0 += step) {
            const int s = r0 < TL ? (r0 >> 13) : 4;
            f32x4 v[2][4];
            const f32x4* src = (const f32x4*)(r0 < TL ? IN_(0) + (size_t)r0 * D : IN_(2) + (size_t)(r0 - TL) * D);
#pragma unroll
            for (int q = 0; q < 2; ++q)
#pragma unroll
                for (int j = 0; j < 4; ++j) v[q][j] = src[q * 256 + lane + 64 * j];
            finish(v, r0, s);
        }
        return;
    }
    int r0 = 2 * gw;
    if (r0 >= NR) return;
    auto ldasg = [&](int rr, int& e, int& rk, float& w) { const size_t o = (size_t)rr * 4 + (lane & 7); e = ae[o]; rk = ark[o]; w = aw[o]; };
    auto ldrows = [&](int rr, int e, int rk, v2u (&x)[2][4], int (&y)[2][4][4]) {
        const v2u* src = (const v2u*)(XA + (size_t)rr * D);
#pragma unroll
        for (int q = 0; q < 2; ++q)
#pragma unroll
            for (int j = 0; j < 4; ++j) x[q][j] = src[q * 256 + lane + 64 * j];
        const int pv = 256 * toff[e] + rk;
#pragma unroll
        for (int q = 0; q < 2; ++q)
#pragma unroll
            for (int k = 0; k < 4; ++k) { const int p = shl_i(pv, q * 4 + k); const int* yrow = (const int*)(YB + (size_t)p * 1024);
#pragma unroll
                for (int j = 0; j < 4; ++j) y[q][k][j] = yrow[lane + 64 * j]; }
    };
    int e1 = 0, k1 = 0; float w1 = 0.f, wcur;
    v2u xc[2][4]; int yc[2][4][4];
    { int e0, k0; ldasg(r0, e0, k0, wcur); if (r0 + step < NR) ldasg(r0 + step, e1, k1, w1); ldrows(r0, e0, k0, xc, yc); }
#pragma unroll 1
    for (; r0 < NR; r0 += step) {
        const int rn = r0 + step; const bool hn = rn < NR;
        v2u xn[2][4]; int yn[2][4][4]; const float wn = w1;
        int e2 = 0, k2 = 0; float w2 = 0.f;
        if (hn) { ldrows(rn, e1, k1, xn, yn); if (rn + step < NR) ldasg(rn + step, e2, k2, w2); }
        asm volatile("" ::: "memory");
        const int s = r0 < TL ? (r0 >> 13) : 4;
        const float* g2 = MODV + (size_t)((l - 1) * 5 + s) * 6144 + 5 * 1024;
        f32x4 v[2][4];
#pragma unroll
        for (int q = 0; q < 2; ++q)
#pragma unroll
            for (int j = 0; j < 4; ++j) { const v2u x = xc[q][j]; f32x4 a = (f32x4){0.f, 0.f, 0.f, 0.f};
#pragma unroll
                for (int k = 0; k < 4; ++k) { const float wk = shl_f(wcur, q * 4 + k); const f32x2_t lo = __builtin_amdgcn_cvt_pk_f32_fp8(yc[q][k][j], false), hi = __builtin_amdgcn_cvt_pk_f32_fp8(yc[q][k][j], true); a += wk * (f32x4){lo[0], lo[1], hi[0], hi[1]}; }
                v[q][j] = (f32x4){bflo(x.x), bfhi(x.x), bflo(x.y), bfhi(x.y)} + ((const f32x4*)g2)[lane + 64 * j] * a; }
        finish(v, r0, s);
        if (hn) {
#pragma unroll
            for (int q = 0; q < 2; ++q)
#pragma unroll
                for (int j = 0; j < 4; ++j) { xc[q][j] = xn[q][j];
#pragma unroll
                    for (int k = 0; k < 4; ++k) yc[q][k][j] = yn[q][k][j]; }
        }
        wcur = wn; e1 = e2; k1 = k2; w1 = w2;
    }
}

struct EpiWin {
    static constexpr bool PERM = true, PERM16 = false, AFTER_DRAIN = false; static constexpr int NVM = MK_MULTI ? 0 : 8;
    unsigned char* ws; int probe;
    __device__ __forceinline__ void prefetch(LAS unsigned char*, const pg8::Unit&, int, int, int, int) const {}
    __device__ __forceinline__ void operator()(const f32x4 (&acc)[2][2][4][2], const pg8::Unit& u, int wr, int wc, int fr, int fq, const LAS unsigned char*) const {
        if (MK_MULTI && (probe == 2 || probe == 4)) { _Pragma("unroll") for (int a = 0; a < 2; ++a) _Pragma("unroll") for (int b2 = 0; b2 < 2; ++b2) _Pragma("unroll") for (int m = 0; m < 4; ++m) _Pragma("unroll") for (int n = 0; n < 2; ++n) asm volatile("" :: "v"(acc[a][b2][m][n])); return; }
        const int pn = u.pn; size_t boff; int ld, cofs;
        if (pn < 2) { boff = WS_QB; ld = 512; cofs = pn * 256; } else if (pn < 4) { boff = WS_KB; ld = 512; cofs = (pn - 2) * 256; }
        else if (pn < 8) { boff = WS_VB; ld = 1024; cofs = (pn - 4) * 256; } else if (pn < 12) { boff = WS_GB; ld = 1024; cofs = (pn - 8) * 256; }
        else if (pn < 14) { boff = WS_CBB; ld = 512; cofs = (pn - 12) * 256; } else { boff = WS_CCB; ld = 512; cofs = (pn - 14) * 128; }
        bf16* base = (bf16*)(ws + boff);
        const int row0 = u.pm * 256 + wr * 64 + fr, col0 = cofs + wc * 32 + 8 * fq;
        const bool rope_on = (pn < 4) && (u.pm < TL / 256);
        if (pn >= 14) {
#pragma unroll
            for (int ai = 0; ai < 2; ++ai)
#pragma unroll
                for (int m = 0; m < 4; ++m) { bf16* rowp = base + (size_t)(row0 + ai * 128 + m * 16) * ld + col0;
                    const f32x4 a = acc[ai][0][m][0] * acc[ai][1][m][0], b = acc[ai][0][m][1] * acc[ai][1][m][1];
                    v4u w; w.x = pk2(a[0], a[1]); w.y = pk2(a[2], a[3]); w.z = pk2(b[0], b[1]); w.w = pk2(b[2], b[3]);
                    if (MK_MULTI && probe == 1) asm volatile("" :: "v"(w)); else *(v4u*)rowp = w; }
            return;
        }
        if (!rope_on) {
#pragma unroll
            for (int ai = 0; ai < 2; ++ai)
#pragma unroll
                for (int m = 0; m < 4; ++m) { bf16* rowp = base + (size_t)(row0 + ai * 128 + m * 16) * ld + col0;
#pragma unroll
                    for (int bj = 0; bj < 2; ++bj) { const f32x4 a = acc[ai][bj][m][0], b = acc[ai][bj][m][1];
                        v4u w; w.x = pk2(a[0], a[1]); w.y = pk2(a[2], a[3]); w.z = pk2(b[0], b[1]); w.w = pk2(b[2], b[3]);
                        if (MK_MULTI && probe == 1) asm volatile("" :: "v"(w)); else *(v4u*)(rowp + bj * 128) = w; } }
            return;
        }
        float frev[4];
#pragma unroll
        for (int k = 0; k < 4; ++k) frev[k] = __builtin_amdgcn_exp2f(-(float)(16 * (wc & 1) + 4 * fq + k) * 0.41524101186092033f) * 0.15915494309189535f;
#pragma unroll
        for (int ai = 0; ai < 2; ++ai)
#pragma unroll
            for (int m = 0; m < 4; ++m) {
                const int r = row0 + ai * 128 + m * 16; bf16* rowp = base + (size_t)r * ld + col0;
                f32x4 c01 = (f32x4){1.f, 0.f, 1.f, 0.f}, c23 = c01;
                if (rope_on) { const int t = r & (SEQ - 1); const float pos = (float)((wc >> 1) ? (t & 63) : (t >> 6));
                    c01 = (f32x4){__builtin_amdgcn_cosf(pos * frev[0]), __builtin_amdgcn_sinf(pos * frev[0]), __builtin_amdgcn_cosf(pos * frev[1]), __builtin_amdgcn_sinf(pos * frev[1])};
                    c23 = (f32x4){__builtin_amdgcn_cosf(pos * frev[2]), __builtin_amdgcn_sinf(pos * frev[2]), __builtin_amdgcn_cosf(pos * frev[3]), __builtin_amdgcn_sinf(pos * frev[3])}; }
#pragma unroll
                for (int bj = 0; bj < 2; ++bj) { const f32x4 a = acc[ai][bj][m][0], b = acc[ai][bj][m][1];
                    f32x4 o0, o1;
                    o0[0] = a[0] * c01[0] - a[1] * c01[1]; o0[1] = a[0] * c01[1] + a[1] * c01[0]; o0[2] = a[2] * c01[2] - a[3] * c01[3]; o0[3] = a[2] * c01[3] + a[3] * c01[2];
                    o1[0] = b[0] * c23[0] - b[1] * c23[1]; o1[1] = b[0] * c23[1] + b[1] * c23[0]; o1[2] = b[2] * c23[2] - b[3] * c23[3]; o1[3] = b[2] * c23[3] + b[3] * c23[2];
                    v4u w; w.x = pk2(o0[0], o0[1]); w.y = pk2(o0[2], o0[3]); w.z = pk2(o1[0], o1[1]); w.w = pk2(o1[2], o1[3]);
                    if (MK_MULTI && probe == 1) asm volatile("" :: "v"(w)); else *(v4u*)(rowp + bj * 128) = w; }
            }
    }
};
struct EpiWout {
    static constexpr bool PERM = true, PERM16 = false, AFTER_DRAIN = false; static constexpr int NVM = 32;
    bf16* X; const bf16* XBp; const bf16* g1h;
    __device__ __forceinline__ void prefetch(LAS unsigned char* pre, const pg8::Unit& u, int wr, int wc, int fr, int fq) const {
        const int s = u.pm < TL / 256 ? (u.pm >> 5) : 4; const bf16* g1 = g1h + (size_t)s * 1024 + u.pn * 256 + wc * 32 + 8 * fq;
        __builtin_amdgcn_global_load_lds((const unsigned*)g1, (LAS unsigned*)pre, 16, 0, 0); __builtin_amdgcn_global_load_lds((const unsigned*)(g1 + 128), (LAS unsigned*)(pre + 1024), 16, 0, 0);
    }
    __device__ __forceinline__ void operator()(const f32x4 (&acc)[2][2][4][2], const pg8::Unit& u, int wr, int wc, int fr, int fq, const LAS unsigned char* pre) const {
        f32x4 gv[2][2];
#pragma unroll
        for (int bj = 0; bj < 2; ++bj) { const v4u x = *(const LAS v4u*)(pre + bj * 1024 + (fq * 16 + fr) * 16); gv[bj][0] = (f32x4){bflo(x.x), bfhi(x.x), bflo(x.y), bfhi(x.y)}; gv[bj][1] = (f32x4){bflo(x.z), bfhi(x.z), bflo(x.w), bfhi(x.w)}; }
        const int row0 = u.pm * 256 + wr * 64 + fr, col0 = u.pn * 256 + wc * 32 + 8 * fq;
#pragma unroll
        for (int ai = 0; ai < 2; ++ai) {
            v4u xb[4][2];
#pragma unroll
            for (int m = 0; m < 4; ++m)
#pragma unroll
                for (int bj = 0; bj < 2; ++bj) xb[m][bj] = *(const v4u*)(XBp + (size_t)(row0 + ai * 128 + m * 16) * D + col0 + bj * 128);
#pragma unroll
            for (int m = 0; m < 4; ++m) { const size_t ro = (size_t)(row0 + ai * 128 + m * 16) * D + col0;
#pragma unroll
                for (int bj = 0; bj < 2; ++bj) { const v4u x = xb[m][bj];
                    const f32x4 v0 = (f32x4){bflo(x.x), bfhi(x.x), bflo(x.y), bfhi(x.y)} + gv[bj][0] * acc[ai][bj][m][0], v1 = (f32x4){bflo(x.z), bfhi(x.z), bflo(x.w), bfhi(x.w)} + gv[bj][1] * acc[ai][bj][m][1];
                    v4u w; w.x = pk2(v0[0], v0[1]); w.y = pk2(v0[2], v0[3]); w.z = pk2(v1[0], v1[1]); w.w = pk2(v1[2], v1[3]);
                    *(v4u*)(X + ro + bj * 128) = w; } }
            asm volatile("" ::: "memory");
        }
    }
};
struct EpiUp {
    static constexpr bool PERM = true, PERM16 = false, AFTER_DRAIN = false; static constexpr int NVM = MK_MULTI ? 0 : 4;
    unsigned char* ACT; const bf16* bup; int probe;
    __device__ __forceinline__ void prefetch(LAS unsigned char* pre, const pg8::Unit& u, int wr, int wc, int fr, int fq) const {
        const bf16* bgp = bup + (size_t)(u.pn >> 3) * 2048 + (u.pn & 7) * 128 + wc * 32 + 8 * fq;
        __builtin_amdgcn_global_load_lds((const unsigned*)bgp, (LAS unsigned*)pre, 16, 0, 0); __builtin_amdgcn_global_load_lds((const unsigned*)(bgp + 1024), (LAS unsigned*)(pre + 1024), 16, 0, 0);
    }
    __device__ __forceinline__ void operator()(const f32x4 (&acc)[2][2][4][2], const pg8::Unit& u, int wr, int wc, int fr, int fq, const LAS unsigned char* pre) const {
        if (MK_MULTI && (probe == 2 || probe == 4)) { _Pragma("unroll") for (int a = 0; a < 2; ++a) _Pragma("unroll") for (int b2 = 0; b2 < 2; ++b2) _Pragma("unroll") for (int m = 0; m < 4; ++m) _Pragma("unroll") for (int n = 0; n < 2; ++n) asm volatile("" :: "v"(acc[a][b2][m][n])); return; }
        struct { v4u bg, bl; } P; P.bg = *(const LAS v4u*)(pre + (fq * 16 + fr) * 16); P.bl = *(const LAS v4u*)(pre + 1024 + (fq * 16 + fr) * 16);
        const int pnl = u.pn & 7, row0 = u.pm * 256 + wr * 64 + fr, col0 = pnl * 128 + wc * 32 + 8 * fq;
        const f32x4 bgv[2] = {(f32x4){bflo(P.bg.x), bfhi(P.bg.x), bflo(P.bg.y), bfhi(P.bg.y)}, (f32x4){bflo(P.bg.z), bfhi(P.bg.z), bflo(P.bg.w), bfhi(P.bg.w)}};
        const f32x4 blv[2] = {(f32x4){bflo(P.bl.x), bfhi(P.bl.x), bflo(P.bl.y), bfhi(P.bl.y)}, (f32x4){bflo(P.bl.z), bfhi(P.bl.z), bflo(P.bl.w), bfhi(P.bl.w)}};
        unsigned char* const rowb = ACT + (size_t)(row0 + (fq & 1) * 16) * 1024 + col0 - 8 * (fq & 1);
#pragma unroll
        for (int ai = 0; ai < 2; ++ai)
#pragma unroll
            for (int mp = 0; mp < 2; ++mp) {
                v2u pc[2];
#pragma unroll
                for (int mm = 0; mm < 2; ++mm) { const int m = 2 * mp + mm;
                    f32x4 o[2];
#pragma unroll
                    for (int n = 0; n < 2; ++n) { const f32x4 g = acc[ai][0][m][n] * 0.03125f + bgv[n], li = acc[ai][1][m][n] * 0.03125f + blv[n];
#pragma unroll
                        for (int q2 = 0; q2 < 2; ++q2) {
                            f32x2_t gg = {fminf(g[2 * q2], 7.f), fminf(g[2 * q2 + 1], 7.f)}; const f32x2_t ll = {__builtin_amdgcn_fmed3f(li[2 * q2], -7.f, 7.f), __builtin_amdgcn_fmed3f(li[2 * q2 + 1], -7.f, 7.f)};
                            const f32x2_t t = gg * (-1.702f * 1.44269504088896f); f32x2_t e2; e2[0] = __builtin_amdgcn_exp2f(t[0]); e2[1] = __builtin_amdgcn_exp2f(t[1]);
                            const f32x2_t d = e2 + 1.0f; f32x2_t rr; rr[0] = __builtin_amdgcn_rcpf(d[0]); rr[1] = __builtin_amdgcn_rcpf(d[1]);
                            const f32x2_t r2 = (gg * rr) * (ll + 1.0f); o[n][2 * q2] = r2[0]; o[n][2 * q2 + 1] = r2[1]; } }
                    const float f8[8] = {o[0][0], o[0][1], o[0][2], o[0][3], o[1][0], o[1][1], o[1][2], o[1][3]}; pc[mm] = pk8_fp8(f8); }
                const auto sx = __builtin_amdgcn_permlane16_swap(pc[0].x, pc[1].x, false, false), sy = __builtin_amdgcn_permlane16_swap(pc[0].y, pc[1].y, false, false);
                if (MK_MULTI && probe == 1) asm volatile("" :: "v"(sx), "v"(sy)); else *(v4u*)(rowb + (size_t)(ai * 128 + mp * 32) * 1024) = (v4u){sx[0], sy[0], sx[1], sy[1]};
                asm volatile("" ::: "memory"); }
    }
};
struct EpiDown {
    static constexpr int NVM = MK_MULTI ? 0 : 8;
    static constexpr bool PERM = true, PERM16 = true, AFTER_DRAIN = false;
    unsigned char* YB; const bf16* bdn; int probe;
    __device__ __forceinline__ void prefetch(LAS unsigned char* pre, const pg8::Unit& u, int wr, int wc, int fr, int fq) const {
        const bf16* bp = bdn + (size_t)(u.pn >> 2) * 1024 + (u.pn & 3) * 256 + wc * 64 + 16 * fq;
        __builtin_amdgcn_global_load_lds((const unsigned*)bp, (LAS unsigned*)pre, 16, 0, 0); __builtin_amdgcn_global_load_lds((const unsigned*)(bp + 8), (LAS unsigned*)(pre + 1024), 16, 0, 0);
    }
    __device__ __forceinline__ void operator()(const f32x4 (&acc)[2][2][4][2], const pg8::Unit& u, int wr, int wc, int fr, int fq, const LAS unsigned char* pre) const {
        struct { v4u bb[2]; } P; P.bb[0] = *(const LAS v4u*)(pre + (fq * 16 + fr) * 16); P.bb[1] = *(const LAS v4u*)(pre + 1024 + (fq * 16 + fr) * 16);
        if (MK_MULTI && (probe == 2 || probe == 4)) { _Pragma("unroll") for (int a = 0; a < 2; ++a) _Pragma("unroll") for (int b2 = 0; b2 < 2; ++b2) _Pragma("unroll") for (int m = 0; m < 4; ++m) _Pragma("unroll") for (int n = 0; n < 2; ++n) asm volatile("" :: "v"(acc[a][b2][m][n])); return; }
        const int pnl = u.pn & 3, row0 = u.pm * 256 + wr * 64 + fr, col0 = pnl * 256 + wc * 64 + 16 * fq;
        f32x4 bv[2][2];
#pragma unroll
        for (int bj = 0; bj < 2; ++bj) { const v4u x = P.bb[bj]; bv[bj][0] = (f32x4){bflo(x.x), bfhi(x.x), bflo(x.y), bfhi(x.y)}; bv[bj][1] = (f32x4){bflo(x.z), bfhi(x.z), bflo(x.w), bfhi(x.w)}; }
#pragma unroll
        for (int ai = 0; ai < 2; ++ai)
#pragma unroll
            for (int m = 0; m < 4; ++m) { unsigned char* rowp = YB + (size_t)(row0 + ai * 128 + m * 16) * 1024 + col0;
                v4u w;
#pragma unroll
                for (int bj = 0; bj < 2; ++bj) { const f32x4 v0 = acc[ai][bj][m][0] * 0.03125f + bv[bj][0], v1 = acc[ai][bj][m][1] * 0.03125f + bv[bj][1];
                    const float f8[8] = {v0[0], v0[1], v0[2], v0[3], v1[0], v1[1], v1[2], v1[3]}; const v2u h = pk8_fp8(f8);
                    if (bj == 0) { w.x = h.x; w.y = h.y; } else { w.z = h.x; w.w = h.y; } }
                if (MK_MULTI && probe == 1) asm volatile("" :: "v"(w)); else *(v4u*)rowp = w; }
    }
};
struct MoeOrder {
    const LAS int* toff; int NT, ncol, shift, G, c; const int* tlist;
    __device__ __forceinline__ int arow(const pg8::Unit& u, int row) const {
        const int e = u.pn >> shift, cnt = toff[33 + e]; int idx = (u.pm - toff[e]) * 256 + row; idx = idx < cnt ? idx : cnt - 1; return tlist[(size_t)e * TT + idx]; }
    __device__ __forceinline__ const int* arow_ptr(const pg8::Unit& u, int row) const { const int e = u.pn >> shift, cnt = toff[33 + e]; int idx = (u.pm - toff[e]) * 256 + row; idx = idx < cnt ? idx : cnt - 1; return tlist + (size_t)e * TT + idx; }
    __device__ __forceinline__ bool next(int i, pg8::Unit& u) const {
        const int x = c & 7, qq = c >> 3, rpx = 32 >> shift;
        const int rt = (G == 256) ? (i * 8 + x) * rpx + (qq >> shift) : (int)(((long)i * G + c) >> shift);
        const int pnl = (G == 256) ? (qq & (ncol - 1)) : (int)(((long)i * G + c) & (ncol - 1));
        if (rt >= NT) return false;
        const int e = ((const LAS unsigned char*)toff)[1024 - 256 + rt];
        u.pm = rt; u.pn = __builtin_amdgcn_readfirstlane(e * ncol + pnl); return true;
    }
    __device__ __forceinline__ void a_ready(const pg8::Unit&) const {}
    __device__ __forceinline__ void done(const pg8::Unit&) const {}
};

__device__ __forceinline__ bf16x8 trpair(const LAS unsigned char* p, int off2) {
    typedef short v4i16_t __attribute__((ext_vector_type(4)));
    const v4i16_t lo = __builtin_amdgcn_ds_read_tr16_b64_v4i16((LAS v4i16_t*)p);
    const v4i16_t hi = __builtin_amdgcn_ds_read_tr16_b64_v4i16((LAS v4i16_t*)(p + off2));
    return (bf16x8){lo[0], lo[1], lo[2], lo[3], hi[0], hi[1], hi[2], hi[3]};
}
__device__ __forceinline__ v4u scale8(v4u x, float s) { v4u o; o.x = pk2(bflo(x.x) * s, bfhi(x.x) * s); o.y = pk2(bflo(x.y) * s, bfhi(x.y) * s); o.z = pk2(bflo(x.z) * s, bfhi(x.z) * s); o.w = pk2(bflo(x.w) * s, bfhi(x.w) * s); return o; }
__device__ __forceinline__ int chunk_row0(int b, int cidx) { return cidx < 2 ? TL + b * LC + cidx * 128 : b * SEQ + (cidx - 2) * 128; }
__device__ __forceinline__ void stage128(LAS unsigned char* dst, const bf16* src, int ld, int tid) {
#pragma unroll
    for (int it = 0; it < 4; ++it) { const int pc = tid + 512 * it, s = pc >> 4, ch = pc & 15; *(LAS v4u*)(dst + s * RPITCH + ch * 16) = *(const v4u*)(src + (size_t)s * ld + ch * 8); }
}
__device__ __forceinline__ void r1_load(v4u (&rk)[4], v4u (&rv)[4], const bf16* KB, const bf16* VB, int u, int tid) {
    const int eh = u & 1, cu = u >> 1, bh = cu / NCH, cidx = cu % NCH, b = bh >> 2, h = bh & 3, row0 = chunk_row0(b, cidx);
#pragma unroll
    for (int it = 0; it < 4; ++it) { const int pc = tid + 512 * it, s = pc >> 4, ch = pc & 15;
        rk[it] = *(const v4u*)(KB + (size_t)(row0 + s) * QKW + h * DK + ch * 8); rv[it] = *(const v4u*)(VB + (size_t)(row0 + s) * RWD + h * DV + eh * 128 + ch * 8); }
}
__device__ __forceinline__ void r1_phase(Frame& F, int l) {
    LAS unsigned char* Kf = F.lds; LAS unsigned char* Kb = F.lds + 128 * RPITCH; LAS unsigned char* Vh = F.lds + 2 * 128 * RPITCH;
    const bf16* KB = WSP(bf16, WS_KB); const bf16* VB = WSP(bf16, WS_VB); unsigned char* KVF = WSP(unsigned char, WS_KVF); unsigned char* KVB = WSP(unsigned char, WS_KVB);
    const int w = F.wave; constexpr int NU = 16 * NCH * 2;
    int u = F.bid;
    if (u >= NU) return;
    v4u rk[4], rv[4];
    r1_load(rk, rv, KB, VB, u, F.tid);
    for (; u < NU; u += F.G) {
        int tid = F.tid; asm volatile("" : "+v"(tid));
        const int lane = tid & 63, g = lane >> 4, i = lane & 15, q = i >> 2, p = i & 3;
        const int eh = u & 1, cu = u >> 1, bh = cu / NCH, cidx = cu % NCH, h = bh & 3;
        const float lgf = logsig(IN_(9)[l * NH + h]), lgb = logsig(IN_(10)[l * NH + h]);
#pragma unroll
        for (int it = 0; it < 4; ++it) { const int pc = tid + 512 * it, s = pc >> 4, ch = pc & 15;
            const float wf = fexp((float)(127 - s) * lgf), wb = fexp((float)s * lgb);
            *(LAS v4u*)(Kf + s * RPITCH + ch * 16) = scale8(rk[it], wf); *(LAS v4u*)(Kb + s * RPITCH + ch * 16) = scale8(rk[it], wb);
            *(LAS v4u*)(Vh + s * RPITCH + ch * 16) = rv[it]; }
        __syncthreads();
        if (u + F.G < NU) r1_load(rk, rv, KB, VB, u + F.G, tid);
        asm volatile("" ::: "memory");
        f32x4 af[8], ab[8];
#pragma unroll
        for (int dt = 0; dt < 8; ++dt) { af[dt] = (f32x4){0.f, 0.f, 0.f, 0.f}; ab[dt] = af[dt]; }
#pragma unroll
        for (int uu = 0; uu < 4; ++uu) {
            const int roff = (32 * uu + 8 * g + q) * RPITCH;
            const bf16x8 vf = trpair(Vh + roff + (16 * w + 4 * p) * 2, 4 * RPITCH);
#pragma unroll
            for (int dt = 0; dt < 8; ++dt) {
                const int dcol = 32 * (dt >> 1) + 8 * p + 4 * (dt & 1);
                const bf16x8 kf = trpair(Kf + roff + dcol * 2, 4 * RPITCH);
                const bf16x8 kb = trpair(Kb + roff + dcol * 2, 4 * RPITCH);
                af[dt] = __builtin_amdgcn_mfma_f32_16x16x32_bf16(kf, vf, af[dt], 0, 0, 0);
                ab[dt] = __builtin_amdgcn_mfma_f32_16x16x32_bf16(kb, vf, ab[dt], 0, 0, 0);
            }
        }
        const size_t o = ((size_t)(bh * NCH + cidx) * DV + 128 * eh + 16 * w + i) * DK + 8 * g;
#pragma unroll
        for (int k = 0; k < 4; ++k) { float ff[8], fb[8];
#pragma unroll
            for (int x = 0; x < 8; ++x) { ff[x] = __builtin_amdgcn_fmed3f(af[2 * k + (x >> 2)][x & 3], -448.f, 448.f); fb[x] = __builtin_amdgcn_fmed3f(ab[2 * k + (x >> 2)][x & 3], -448.f, 448.f); }
            *(v2u*)(KVF + o + 32 * k) = pk8_fp8(ff); *(v2u*)(KVB + o + 32 * k) = pk8_fp8(fb); }
        __syncthreads();
    }
}
__device__ __forceinline__ void conv_phase(Frame& F, int l) {
    const bf16* CB = WSP(bf16, WS_CBB); const bf16* CU = WSP(bf16, WS_CCB); unsigned char* MIX = WSP(unsigned char, WS_MIX);
    const float* cw = IN_(11) + (size_t)l * 3 * CWD;
    for (int idx = F.bid * 512 + F.tid; idx < TT * 64; idx += F.G * 512) {
        const int r = idx >> 6, ch0 = (idx & 63) * 8;
        const bool hp = r < TL ? ((r & 63) != 0) : ((r & 255) != 0), hn = r < TL ? ((r & 63) != 63) : ((r & 255) != 255);
        const size_t o = (size_t)r * CWD + ch0;
        const v4u u1 = *(const v4u*)(CU + o), bb = *(const v4u*)(CB + o);
        v4u u0 = (v4u){0u, 0u, 0u, 0u}, u2 = u0;
        if (hp) u0 = *(const v4u*)(CU + o - CWD);
        if (hn) u2 = *(const v4u*)(CU + o + CWD);
        const f32x4 w0a = *(const f32x4*)(cw + ch0), w0b = *(const f32x4*)(cw + ch0 + 4), w1a = *(const f32x4*)(cw + CWD + ch0), w1b = *(const f32x4*)(cw + CWD + ch0 + 4), w2a = *(const f32x4*)(cw + 2 * CWD + ch0), w2b = *(const f32x4*)(cw + 2 * CWD + ch0 + 4);
        float res[8];
#pragma unroll
        for (int k = 0; k < 4; ++k) {
            const unsigned a0 = u0[k], a1 = u1[k], a2 = u2[k], cbw = bb[k];
            const float wl0 = k < 2 ? w0a[2 * k] : w0b[2 * k - 4], wh0 = k < 2 ? w0a[2 * k + 1] : w0b[2 * k - 3];
            const float wl1 = k < 2 ? w1a[2 * k] : w1b[2 * k - 4], wh1 = k < 2 ? w1a[2 * k + 1] : w1b[2 * k - 3];
            const float wl2 = k < 2 ? w2a[2 * k] : w2b[2 * k - 4], wh2 = k < 2 ? w2a[2 * k + 1] : w2b[2 * k - 3];
            res[2 * k] = bflo(cbw) * (bflo(a0) * wl0 + bflo(a1) * wl1 + bflo(a2) * wl2);
            res[2 * k + 1] = bfhi(cbw) * (bfhi(a0) * wh0 + bfhi(a1) * wh1 + bfhi(a2) * wh2);
        }
#pragma unroll
        for (int k = 0; k < 8; ++k) res[k] = __builtin_amdgcn_fmed3f(res[k], -448.f, 448.f);
        *(v2u*)(MIX + (size_t)r * MIXW + RWD + ch0) = pk8_fp8(res);
    }
}
__device__ __forceinline__ int scan_order(int dir, int o) { return dir == 0 ? o : (o == 0 ? 1 : (o == 1 ? 0 : 67 - o)); }
__device__ __forceinline__ void scan_phase(Frame& F, int l) {
    for (int gid = F.bid * 512 + F.tid; gid < 2 * 16 * 4096; gid += F.G * 512) {
        const int dir = gid >> 16, rem = gid & 65535, bh = rem >> 12, vec = rem & 4095, h = bh & 3;
        const size_t boff = (size_t)bh * NCH * 32768 + vec * 8;
        const unsigned char* base = (dir ? WSP(unsigned char, WS_KVB) : WSP(unsigned char, WS_KVF)) + boff; unsigned char* obase = (dir ? WSP(unsigned char, WS_SB) : WSP(unsigned char, WS_SF)) + boff;
        const float dc = expf(128.f * logsig((dir ? IN_(10) : IN_(9))[l * NH + h]));
        float s[8];
#pragma unroll
        for (int k = 0; k < 8; ++k) s[k] = 0.f;
#pragma unroll 1
        for (int bt = 0; bt < 6; ++bt) {
            v2u kv[11];
#pragma unroll
            for (int j = 0; j < 11; ++j) kv[j] = *(const v2u*)(base + (size_t)scan_order(dir, bt * 11 + j) * 32768);
#pragma unroll
            for (int j = 0; j < 11; ++j) {
                { float f8[8];
#pragma unroll
                  for (int k = 0; k < 8; ++k) f8[k] = __builtin_amdgcn_fmed3f(s[k] * 0.25f, -448.f, 448.f);
                  *(v2u*)(obase + (size_t)scan_order(dir, bt * 11 + j) * 32768) = pk8_fp8(f8); }
#pragma unroll
                for (int k2 = 0; k2 < 2; ++k2) { const int wd = (int)kv[j][k2]; const f32x2_t lo = __builtin_amdgcn_cvt_pk_f32_fp8(wd, false), hi = __builtin_amdgcn_cvt_pk_f32_fp8(wd, true);
                    s[4 * k2] = s[4 * k2] * dc + lo[0]; s[4 * k2 + 1] = s[4 * k2 + 1] * dc + lo[1]; s[4 * k2 + 2] = s[4 * k2 + 2] * dc + hi[0]; s[4 * k2 + 3] = s[4 * k2 + 3] * dc + hi[1]; }
            }
        }
    }
}
__device__ __forceinline__ void ld128(v4u (&dst)[4], const bf16* src, int ld, int tid) {
#pragma unroll
    for (int it = 0; it < 4; ++it) { const int pc = tid + 512 * it, s = pc >> 4, ch = pc & 15; dst[it] = *(const v4u*)(src + (size_t)s * ld + ch * 8); }
}
__device__ __forceinline__ void ld128f8(v2u (&dst)[4], const unsigned char* src, int tid) {
#pragma unroll
    for (int it = 0; it < 4; ++it) { const int pc = tid + 512 * it; dst[it] = *(const v2u*)(src + (size_t)pc * 8); }
}
__device__ __forceinline__ void st128f8(LAS unsigned char* dst, const v2u (&r)[4], int tid) {
#pragma unroll
    for (int it = 0; it < 4; ++it) { const int pc = tid + 512 * it, s = pc >> 4, ch = pc & 15;
        const f32x2_t a = __builtin_amdgcn_cvt_pk_f32_fp8((int)r[it].x, false), b = __builtin_amdgcn_cvt_pk_f32_fp8((int)r[it].x, true), c = __builtin_amdgcn_cvt_pk_f32_fp8((int)r[it].y, false), d = __builtin_amdgcn_cvt_pk_f32_fp8((int)r[it].y, true);
        v4u o; o.x = pk2(a[0], a[1]); o.y = pk2(b[0], b[1]); o.z = pk2(c[0], c[1]); o.w = pk2(d[0], d[1]);
        *(LAS v4u*)(dst + s * RPITCH + ch * 16) = o; }
}
__device__ __forceinline__ void st128(LAS unsigned char* dst, const v4u (&r)[4], int tid) {
#pragma unroll
    for (int it = 0; it < 4; ++it) { const int pc = tid + 512 * it, s = pc >> 4, ch = pc & 15; *(LAS v4u*)(dst + s * RPITCH + ch * 16) = r[it]; }
}
__device__ __forceinline__ void r3_phase(Frame& F, int l) {
    LAS unsigned char* Ks = F.lds; LAS unsigned char* Vh = F.lds + 128 * RPITCH; LAS unsigned char* Sf = F.lds + 2 * 128 * RPITCH; LAS unsigned char* Sb = F.lds + 3 * 128 * RPITCH;
    const bf16* QB = WSP(bf16, WS_QB); const bf16* KB = WSP(bf16, WS_KB); const bf16* VB = WSP(bf16, WS_VB); const bf16* GB = WSP(bf16, WS_GB);
    const unsigned char* SFg = WSP(unsigned char, WS_SF); const unsigned char* SBg = WSP(unsigned char, WS_SB); unsigned char* MIX = WSP(unsigned char, WS_MIX);
    const int w = F.wave;
    const bool last = (l == DEPTH - 1);
    const int NU = last ? 16 * 64 : 16 * NCH, per = last ? 64 : NCH, cofs = last ? 2 : 0;
    int j = F.bid;
    if (j >= NU) return;
    v4u rk[4], rv[4]; v2u rf[4], rb[4];
    { const int bh = j / per, cidx = cofs + j % per, row0 = chunk_row0(bh >> 2, cidx), h = bh & 3; const size_t so = (size_t)(bh * NCH + cidx) * DV * DK;
      ld128(rk, KB + (size_t)row0 * QKW + h * DK, QKW, F.tid); ld128(rv, VB + (size_t)row0 * RWD + h * DV, RWD, F.tid); ld128f8(rf, SFg + so, F.tid); ld128f8(rb, SBg + so, F.tid); }
    for (; j < NU; j += F.G) {
        const int bh = j / per, cidx = cofs + j % per, b = bh >> 2, h = bh & 3;
        int tid = F.tid; asm volatile("" : "+v"(tid));
        const int lane = tid & 63, g = lane >> 4, i = lane & 15, q = i >> 2, p = i & 3;
        const int row0 = chunk_row0(b, cidx), c = 16 * w + i, r = row0 + c;
        const float lgf = logsig(IN_(9)[l * NH + h]), lgb = logsig(IN_(10)[l * NH + h]);
        const size_t so = (size_t)(bh * NCH + cidx) * DV * DK;
        v4u qv[4];
        const float qfs = 4.f * fexp((float)(c + 1) * lgf), qbs = 4.f * fexp((float)(128 - c) * lgb);
#pragma unroll
        for (int uu = 0; uu < 4; ++uu) qv[uu] = *(const v4u*)(QB + (size_t)r * QKW + h * DK + 32 * uu + 8 * g);
        st128(Ks, rk, tid); st128(Vh, rv, tid); st128f8(Sf, rf, tid); st128f8(Sb, rb, tid);
        __syncthreads();
        ld128(rv, VB + (size_t)row0 * RWD + h * DV + 128, RWD, tid); ld128f8(rf, SFg + so + (size_t)128 * DK, tid); ld128f8(rb, SBg + so + (size_t)128 * DK, tid);
        asm volatile("" ::: "memory");
        v4u pf[4];
        f32x4 acc[2][8];
        v2u gq[16];
        {
            f32x4 sc[8];
#pragma unroll
            for (int st = 0; st < 8; ++st) { sc[st] = (f32x4){0.f, 0.f, 0.f, 0.f};
#pragma unroll
                for (int uu = 0; uu < 4; ++uu) { const bf16x8 kf = *(const LAS bf16x8*)(Ks + (16 * st + i) * RPITCH + (32 * uu + 8 * g) * 2);
                    sc[st] = __builtin_amdgcn_mfma_f32_16x16x32_bf16(kf, __builtin_bit_cast(bf16x8, qv[uu]), sc[st], 0, 0, 0); }
                asm volatile("" ::: "memory"); }
#pragma unroll
            for (int st = 0; st < 8; ++st)
#pragma unroll
                for (int rg = 0; rg < 4; ++rg) { const int s = 16 * st + 4 * g + rg; const float m = fexp(c >= s ? (float)(c - s) * lgf : (float)(s - c) * lgb); sc[st][rg] *= m; }
#pragma unroll
            for (int uu = 0; uu < 4; ++uu) { pf[uu].x = pk2(sc[2 * uu][0], sc[2 * uu][1]); pf[uu].y = pk2(sc[2 * uu][2], sc[2 * uu][3]); pf[uu].z = pk2(sc[2 * uu + 1][0], sc[2 * uu + 1][1]); pf[uu].w = pk2(sc[2 * uu + 1][2], sc[2 * uu + 1][3]); }
        }
#pragma unroll
        for (int eh = 0; eh < 2; ++eh) {
            if (eh == 1) {
                __syncthreads();
                st128(Vh, rv, tid); st128f8(Sf, rf, tid); st128f8(Sb, rb, tid);
                __syncthreads();
                const int jn = j + F.G;
                if (jn < NU) { const int bh2 = jn / per, cidx2 = cofs + jn % per, row2 = chunk_row0(bh2 >> 2, cidx2), h2 = bh2 & 3; const size_t so2 = (size_t)(bh2 * NCH + cidx2) * DV * DK;
                    ld128(rk, KB + (size_t)row2 * QKW + h2 * DK, QKW, tid); ld128(rv, VB + (size_t)row2 * RWD + h2 * DV, RWD, tid); ld128f8(rf, SFg + so2, tid); ld128f8(rb, SBg + so2, tid); }
#pragma unroll
                for (int e2 = 0; e2 < 16; ++e2) gq[e2] = *(const v2u*)(GB + (size_t)r * RWD + h * DV + 128 * (e2 >> 3) + 16 * (e2 & 7) + 4 * g);
                asm volatile("" ::: "memory");
            }
#pragma unroll
            for (int et = 0; et < 8; ++et) {
                f32x4 a = (f32x4){0.f, 0.f, 0.f, 0.f};
#pragma unroll
                for (int uu = 0; uu < 4; ++uu) {
                    const bf16x8 vf = trpair(Vh + (32 * uu + 4 * g + q) * RPITCH + (16 * et + 4 * p) * 2, 16 * RPITCH);
                    a = __builtin_amdgcn_mfma_f32_16x16x32_bf16(vf, __builtin_bit_cast(bf16x8, pf[uu]), a, 0, 0, 0); }
                f32x4 xf = (f32x4){0.f, 0.f, 0.f, 0.f}, xb = xf;
#pragma unroll
                for (int uu = 0; uu < 4; ++uu) { const bf16x8 sf = *(const LAS bf16x8*)(Sf + (16 * et + i) * RPITCH + (32 * uu + 8 * g) * 2);
                    xf = __builtin_amdgcn_mfma_f32_16x16x32_bf16(sf, __builtin_bit_cast(bf16x8, qv[uu]), xf, 0, 0, 0); }
#pragma unroll
                for (int uu = 0; uu < 4; ++uu) { const bf16x8 sb = *(const LAS bf16x8*)(Sb + (16 * et + i) * RPITCH + (32 * uu + 8 * g) * 2);
                    xb = __builtin_amdgcn_mfma_f32_16x16x32_bf16(sb, __builtin_bit_cast(bf16x8, qv[uu]), xb, 0, 0, 0); }
                acc[eh][et] = a + qfs * xf + qbs * xb;
                asm volatile("" ::: "memory");
            }
        }
        float ss = 0.f;
#pragma unroll
        for (int eh = 0; eh < 2; ++eh)
#pragma unroll
            for (int et = 0; et < 8; ++et) { const f32x4 a = acc[eh][et]; ss += (a[0] * a[0] + a[1] * a[1]) + (a[2] * a[2] + a[3] * a[3]); }
        ss += shx_f(ss, 16, lane); ss += shx_f(ss, 32, lane);
        const float rn = __builtin_amdgcn_rsqf(ss * (1.f / DV) + EPS);
#pragma unroll
        for (int eh = 0; eh < 2; ++eh)
#pragma unroll
            for (int et = 0; et < 8; ++et) { const int ecol = h * DV + 128 * eh + 16 * et + 4 * g; const v2u gv = gq[eh * 8 + et];
                const float g0 = bflo(gv.x), g1 = bfhi(gv.x), g2 = bflo(gv.y), g3 = bfhi(gv.y); const f32x4 a = acc[eh][et] * rn;
                int o = __builtin_amdgcn_cvt_pk_fp8_f32(g0 * fsigm(g0) * a[0], g1 * fsigm(g1) * a[1], 0, false); o = __builtin_amdgcn_cvt_pk_fp8_f32(g2 * fsigm(g2) * a[2], g3 * fsigm(g3) * a[3], o, true);
                *(int*)(MIX + (size_t)r * MIXW + ecol) = o; if (et & 1) asm volatile("" ::: "memory"); }
        __syncthreads();
    }
}

constexpr int RWP = 2064;
__device__ __forceinline__ void top4_of8(const float (&v)[8], const int (&id)[8], float (&tv)[4], int (&ti)[4]) {
    float w[8];
#pragma unroll
    for (int k = 0; k < 8; ++k) w[k] = v[k];
#pragma unroll
    for (int k = 0; k < 4; ++k) { float bv = w[0]; int bi = id[0]; int bp = 0;
#pragma unroll
        for (int m = 1; m < 8; ++m) { const bool better = w[m] > bv || (w[m] == bv && id[m] < bi); bv = better ? w[m] : bv; bi = better ? id[m] : bi; bp = better ? m : bp; }
        tv[k] = bv; ti[k] = bi;
#pragma unroll
        for (int m = 0; m < 8; ++m) w[m] = (m == bp) ? -3.0e38f : w[m]; }
}
__device__ __forceinline__ void router_phase(Frame& F, int l) {
    LAS unsigned char* WH = F.lds; LAS unsigned char* WL = F.lds + NE * RWP;
    LAS int* lcnt = (LAS int*)(F.lds + 2 * NE * RWP); LAS int* lbase = lcnt + 32;
    LAS unsigned char* le = (LAS unsigned char*)(lcnt + 64); LAS unsigned short* lrk = (LAS unsigned short*)(le + 1024);
    LAS float* PRM = (LAS float*)(F.lds + 135168);
    const int NR = (l == DEPTH - 1) ? TL : TT; const int ntile = NR / 16;
    const int tb = (int)(((long)F.bid * ntile) / F.G), te = (int)(((long)(F.bid + 1) * ntile) / F.G);
    const int lane = F.lane, g = lane >> 4, i = lane & 15;
    const bf16* X = WSP(bf16, WS_X); unsigned char* HB8 = WSP(unsigned char, WS_HB8); const float* MODV = WSP(float, WS_MODV);
    int* ae = WSP(int, WS_ASG); int* ark = WSP(int, WS_ASG + 1 * MiB); float* aw = WSP(float, WS_ASG + 3 * MiB);
    { const v4u* src = WSP(v4u, WS_RWHL) + (size_t)l * 2 * NE * 128;
#pragma unroll
      for (int it = 0; it < 16; ++it) { const int pc = F.tid + 512 * it, hl = pc >> 12, e = (pc >> 7) & 31, c16 = pc & 127; *(LAS v4u*)(F.lds + hl * NE * RWP + e * RWP + c16 * 16) = src[pc]; } }
    const int s_lo = (16 * tb) < TL ? ((16 * tb) >> 13) : 4, s_hi = (16 * te - 1) < TL ? ((16 * te - 1) >> 13) : 4;
    { const float* nm = IN_(7) + (size_t)l * D;
#pragma unroll
      for (int it = 0; it < 4; ++it) { const int idx = F.tid + 512 * it, seg = idx >> 10, col = idx & 1023; const float* mv = MODV + (size_t)(l * 5 + (seg ? s_hi : s_lo)) * 6144;
          PRM[seg * 2048 + col] = nm[col] * (1.f + mv[4 * 1024 + col]); PRM[seg * 2048 + 1024 + col] = mv[3 * 1024 + col]; } }
    if (F.tid < 64) lcnt[F.tid] = 0;
    if (te - tb > 9 && F.tid == 0) atomicAdd(&F.ctl[CW_ERR], 1u);
    __syncthreads();
    for (int tile = tb + F.wave; tile < te; tile += NWAVES) {
        const int r = 16 * tile + i; const int s = r < TL ? (r >> 13) : 4;
        const LAS float* pa = PRM + ((s == s_lo) ? 0 : 2048) + 8 * g; const LAS float* ps = pa + 1024;
        const v4u* xp = (const v4u*)(X + (size_t)r * D) + g;
        v4u xr[32];
#pragma unroll
        for (int u = 0; u < 32; ++u) xr[u] = xp[4 * u];
        float ss = 0.f;
#pragma unroll
        for (int u = 0; u < 32; ++u) { const v4u x = xr[u]; const float a0 = bflo(x.x), a1 = bfhi(x.x), a2 = bflo(x.y), a3 = bfhi(x.y), c0 = bflo(x.z), c1 = bfhi(x.z), c2 = bflo(x.w), c3 = bfhi(x.w);
            ss += (a0 * a0 + a1 * a1) + (a2 * a2 + a3 * a3) + (c0 * c0 + c1 * c1) + (c2 * c2 + c3 * c3); }
        ss += shx_f(ss, 16, lane); ss += shx_f(ss, 32, lane);
        const float rms = 1.f / sqrtf(ss * (1.f / D) + EPS);
#pragma unroll
        for (int u = 0; u < 32; ++u) asm volatile("" : "+v"(xr[u]));
        f32x4 acc[2]; acc[0] = (f32x4){0.f, 0.f, 0.f, 0.f}; acc[1] = acc[0];
#pragma unroll
        for (int u = 0; u < 32; ++u) {
            const int col = 32 * u + 8 * g;
            const v4u xx = xr[u]; const f32x4 xa = (f32x4){bflo(xx.x), bfhi(xx.x), bflo(xx.y), bfhi(xx.y)}, xb = (f32x4){bflo(xx.z), bfhi(xx.z), bflo(xx.w), bfhi(xx.w)};
            const f32x4 ga = *(const LAS f32x4*)(pa + 32 * u), gb = *(const LAS f32x4*)(pa + 32 * u + 4), ha = *(const LAS f32x4*)(ps + 32 * u), hb = *(const LAS f32x4*)(ps + 32 * u + 4);
            const f32x4 h0 = xa * rms * ga + ha, h1 = xb * rms * gb + hb;
            v4u hi, lo; hi.x = pk2(h0[0], h0[1]); hi.y = pk2(h0[2], h0[3]); hi.z = pk2(h1[0], h1[1]); hi.w = pk2(h1[2], h1[3]);
            lo.x = pk2(h0[0] - bflo(hi.x), h0[1] - bfhi(hi.x)); lo.y = pk2(h0[2] - bflo(hi.y), h0[3] - bfhi(hi.y)); lo.z = pk2(h1[0] - bflo(hi.z), h1[1] - bfhi(hi.z)); lo.w = pk2(h1[2] - bflo(hi.w), h1[3] - bfhi(hi.w));
            { const float f8[8] = {h0[0], h0[1], h0[2], h0[3], h1[0], h1[1], h1[2], h1[3]}; *(v2u*)(HB8 + (size_t)r * D + col) = pk8_fp8(f8); }
#pragma unroll
            for (int t = 0; t < 2; ++t) { const bf16x8 wh = *(const LAS bf16x8*)(WH + (16 * t + i) * RWP + col * 2), wl = *(const LAS bf16x8*)(WL + (16 * t + i) * RWP + col * 2);
                acc[t] = __builtin_amdgcn_mfma_f32_16x16x32_bf16(wh, __builtin_bit_cast(bf16x8, hi), acc[t], 0, 0, 0);
                acc[t] = __builtin_amdgcn_mfma_f32_16x16x32_bf16(wh, __builtin_bit_cast(bf16x8, lo), acc[t], 0, 0, 0);
                acc[t] = __builtin_amdgcn_mfma_f32_16x16x32_bf16(wl, __builtin_bit_cast(bf16x8, hi), acc[t], 0, 0, 0); }
            asm volatile("" ::: "memory");
        }
        float v8[8]; int id8[8];
#pragma unroll
        for (int t = 0; t < 2; ++t)
#pragma unroll
            for (int rg = 0; rg < 4; ++rg) { const int e = 16 * t + 4 * g + rg; id8[4 * t + rg] = e; v8[4 * t + rg] = acc[t][rg] + IN_(14)[l * NE + e]; }
        float tv[4]; int ti[4];
        top4_of8(v8, id8, tv, ti);
#pragma unroll
        for (int step = 16; step <= 32; step <<= 1) {
#pragma unroll
            for (int k = 0; k < 4; ++k) { v8[k] = tv[k]; id8[k] = ti[k]; v8[4 + k] = shx_f(tv[k], step, lane); id8[4 + k] = shx_i(ti[k], step, lane); }
            top4_of8(v8, id8, tv, ti);
        }
        const float e1 = expf(tv[1] - tv[0]), e2 = expf(tv[2] - tv[0]), e3 = expf(tv[3] - tv[0]); const float inv = 1.f / (1.f + e1 + e2 + e3);
        if (lane < 16) {
            const int rl = 16 * (tile - tb) + i; const float wk[4] = {inv, e1 * inv, e2 * inv, e3 * inv};
#pragma unroll
            for (int k = 0; k < 4; ++k) { const int e = ti[k]; const int lr = __hip_atomic_fetch_add(lcnt + e, 1, __ATOMIC_RELAXED, __HIP_MEMORY_SCOPE_WORKGROUP);
                le[rl * 4 + k] = (unsigned char)e; lrk[rl * 4 + k] = (unsigned short)lr; ae[(size_t)r * 4 + k] = e; aw[(size_t)r * 4 + k] = wk[k]; }
        }
    }
    __syncthreads();
    if (F.tid < NE) lbase[F.tid] = (int)atomicAdd(&F.ctl[CW_GCNT + (((MK_MULTI && F.ka->probe == 3) ? l + 4 : l) * 32 + F.tid) * 64], (unsigned)lcnt[F.tid]);
    __syncthreads();
    { int* tlist = WSP(int, WS_TLIST);
      for (int a = F.tid; a < (te - tb) * 64; a += 512) { const int e = le[a], rk = lbase[e] + (int)lrk[a]; ark[(size_t)tb * 64 + a] = rk; tlist[(size_t)e * TT + rk] = 16 * tb + (a >> 2); } }
}
#ifndef FILL_WIN
#define FILL_WIN 1
#define FILL_R3 1
#define FILL_WOUT 1
#endif
#if defined(BAR_EARLY_WB)
#define EARLY_WB() do { asm volatile("s_waitcnt vmcnt(0)" ::: "memory"); __syncthreads(); if (threadIdx.x == 0) { __builtin_amdgcn_fence(__ATOMIC_RELEASE, "agent"); asm volatile("s_waitcnt vmcnt(0)" ::: "memory"); } } while (0)
#else
#define EARLY_WB() do { } while (0)
#endif
#ifndef GP_ALIGN
#define GP_ALIGN true
#endif
#ifndef GP_SP2
#define GP_SP2 true
#endif
constexpr int NPH = 9, NSTEPS = 1 + DEPTH * NPH + 1;
template <int PB> __global__ void __launch_bounds__(NWAVES * 64, 2) mk_fwd_t(Args args) {
    extern __shared__ __attribute__((aligned(16))) unsigned char lds[];
    const int wave0 = __builtin_amdgcn_readfirstlane((int)threadIdx.x >> 6);
    for (int u = threadIdx.x; u < (LDS_BYTES - MISC_OFF) / 4; u += NWAVES * 64) ((LAS unsigned*)((LAS unsigned char*)lds + MISC_OFF))[u] = 0u;
    __syncthreads();
#if MK_MULTI
#define GRID_BAR() do { } while (0)
#else
    (void)xcd_barrier_post((unsigned*)args.ws + CW_BAR, (volatile LAS unsigned*)((LAS unsigned char*)lds + MISC_OFF) + 8);
#define GRID_BAR() do { const CAS Args* kb_ = (const CAS Args*)__builtin_amdgcn_kernarg_segment_ptr(); asm volatile("" : "+s"(kb_)); XcdBarrier bar_; bar_.bar = (unsigned*)kb_->ws + CW_BAR; bar_.x = xb_xcc_id(); \
        bar_.st = (volatile LAS unsigned*)((LAS unsigned char*)lds + MISC_OFF) + 8; EARLY_WB(); xcd_barrier(bar_); } while (0)
#endif
#if MK_MULTI
    const int lo = args.ph_lo, hi = args.ph_hi;
#else
    constexpr int lo = 0, hi = NSTEPS;
#endif
#ifndef PH_MASK
#define PH_MASK 0xFFFF
#endif
#define PON(j) (((PH_MASK) >> (j)) & 1)
#define IN(k) (lo <= (k) && (k) < hi)
#define SEAM(k) do { if (IN(k) && IN((k) + 1)) GRID_BAR(); } while (0)

    if (PON(10) && IN(0)) { MKFRAME(F); p0_prologue(F); SEAM(0); }
    for (int l = 0; l < DEPTH; ++l) {
        const int sb = 1 + l * NPH;
        const bool last = (l == DEPTH - 1);
        if (PON(0) && IN(sb + 0)) { MKFRAME(F); row_phase<false>(F, l); SEAM(sb + 0); }
        if (PON(1) && IN(sb + 1)) { MKFRAME(F);
            pg8::Gemm g{WSP(bf16, WS_HB), WSP(bf16, WS_WINT) + (size_t)l * INW * 1024, TT, INW, (MK_MULTI && PB == 4) ? D / 2 : D}; pg8::StaticOrder S; S.init(TT, INW, F.G, F.bid);
            EpiWin E{F.ws, PB};
            pg8::gemm_phase<EpiWin, pg8::StaticOrder, GP_ALIGN, GP_SP2>(F.lds, g, S, E, F.tid);
            { MKFRAME(F2); if (9 * F2.G + F2.bid >= (TT / 256) * (INW / 256)) convert_fill(F2, l, 1, FILL_WIN); }
            SEAM(sb + 1);
        }
        if (PON(2) && IN(sb + 2)) { MKFRAME(F); r1_phase(F, l); conv_phase(F, l); SEAM(sb + 2); }
        if (PON(3) && IN(sb + 3)) { MKFRAME(F); scan_phase(F, l); SEAM(sb + 3); }
        if (PON(4) && IN(sb + 4)) { MKFRAME(F); r3_phase(F, l); { MKFRAME(F2); if (4 * F2.G + F2.bid >= 16 * NCH) { __syncthreads(); convert_fill(F2, l, 1, FILL_R3); } } SEAM(sb + 4); }
        if (PON(5) && IN(sb + 5)) { MKFRAME(F);
            const int M = last ? TL : TT;
            pg8::Gemm g{WSP(bf16, WS_MIX), (const bf16*)(WSP(unsigned char, WS_WOUTT) + (size_t)l * 1024 * MIXW), M, D, MIXW / 2}; pg8::StaticOrder S; S.init(M, D, F.G, F.bid);
            EpiWout E{WSP(bf16, WS_X), WSP(bf16, WS_XB), WSP(bf16, WS_G1H) + (size_t)l * 5 * 1024};
            pg8::gemm_phase<EpiWout, pg8::StaticOrder, GP_ALIGN, GP_SP2, true>(F.lds, g, S, E, F.tid);
            { MKFRAME(F2); if (2 * F2.G + F2.bid >= (TT / 256) * (D / 256)) convert_fill(F2, l, 1, FILL_WOUT); }
            SEAM(sb + 5);
        }
        if (PON(6) && IN(sb + 6)) { MKFRAME(F); router_phase(F, l); { MKFRAME(F2); __syncthreads(); convert_fill(F2, l, 1, -1); } SEAM(sb + 6); }
        if (PON(7) && IN(sb + 7)) { MKFRAME(F);
            moe_offsets(F, l);
            const LAS int* toff = (const LAS int*)(F.lds + MISC_OFF + 256); const int NT = toff[32];
            pg8::Gemm g{(const bf16*)WSP(unsigned char, WS_HB8), (const bf16*)(WSP(unsigned char, WS_WUPT) + (size_t)l * NE * 2048 * 1024), NT * 256, NE * 2048, (MK_MULTI && PB == 4) ? D / 4 : D / 2};
            MoeOrder S{toff, NT, 8, 3, F.G, F.bid, WSP(int, WS_TLIST)};
            EpiUp E{WSP(unsigned char, WS_ACT), WSP(bf16, WS_BUPH) + (size_t)l * NE * 2048, PB};
            pg8::gemm_phase<EpiUp, MoeOrder, GP_ALIGN, GP_SP2, true, true>(F.lds, g, S, E, F.tid);
            SEAM(sb + 7);
        }
        if (PON(8) && IN(sb + 8)) { MKFRAME(F);
            moe_offsets(F, l);
            const LAS int* toff = (const LAS int*)(F.lds + MISC_OFF + 256); const int NT = toff[32];
            pg8::Gemm g{WSP(bf16, WS_ACT), (const bf16*)(WSP(unsigned char, WS_WDNT) + (size_t)l * NE * 1024 * 1024), NT * 256, NE * 1024, (MK_MULTI && PB == 4) ? DFF / 4 : DFF / 2};
            MoeOrder S{toff, NT, 4, 2, F.G, F.bid, nullptr};
            EpiDown E{WSP(unsigned char, WS_YB), WSP(bf16, WS_BDNH) + (size_t)l * NE * 1024, PB};
            pg8::gemm_phase<EpiDown, MoeOrder, GP_ALIGN, GP_SP2, true>(F.lds, g, S, E, F.tid);
            SEAM(sb + 8);
        }
    }
    if (PON(11) && IN(NSTEPS - 1)) { MKFRAME(F); row_phase<true>(F, DEPTH); }
#undef IN
#undef SEAM
}

#define mk_fwd mk_fwd_t<0>
extern "C" void kernel_launch(void* const* d_in, const int* in_sizes, int n_in, void* d_out, int out_size, void* d_ws, size_t ws_size, hipStream_t stream) {
    static int grid = 0;
    if (grid == 0) {
        if (n_in != 20 || out_size != TL * D || ws_size < WS_END) { fprintf(stderr, "kernel_launch: unexpected shapes (n_in %d out %d ws %zu)\n", n_in, out_size, ws_size); grid = -1; return; }
        int dev = 0, cus = 0, per_cu = 0;
        if (hipGetDevice(&dev) != hipSuccess || hipDeviceGetAttribute(&cus, hipDeviceAttributeMultiprocessorCount, dev) != hipSuccess) { grid = -1; return; }
#if MK_MULTI && defined(DUP_PROBE)
        (void)hipFuncSetAttribute((const void*)mk_fwd_t<DUP_PROBE>, hipFuncAttributeMaxDynamicSharedMemorySize, LDS_BYTES);
#endif
        if (hipFuncSetAttribute((const void*)mk_fwd, hipFuncAttributeMaxDynamicSharedMemorySize, LDS_BYTES) != hipSuccess) { fprintf(stderr, "kernel_launch: hipFuncSetAttribute failed\n"); grid = -1; return; }
        if (hipOccupancyMaxActiveBlocksPerMultiprocessor(&per_cu, (const void*)mk_fwd, NWAVES * 64, LDS_BYTES) != hipSuccess || per_cu < 1) fprintf(stderr, "kernel_launch: occupancy query reports %d blocks per CU\n", per_cu);
        (void)hipGetLastError();
        grid = cus;
    }
    if (grid < 0) return;
    if (hipMemsetAsync((char*)d_ws + WS_CTL, 0, CTL_ZERO_BYTES, stream) != hipSuccess) return;
    Args a{};
    for (int i = 0; i < 20; ++i) a.in[i] = (const float*)d_in[i];
    a.out = (float*)d_out; a.ws = (unsigned char*)d_ws;
#if MK_MULTI
#ifndef DUP_MASK
#define DUP_MASK 0
#endif
    for (int st = 0; st < NSTEPS; ++st) { a.ph_lo = st; a.ph_hi = st + 1; hipLaunchKernelGGL(mk_fwd, dim3(grid), dim3(NWAVES * 64), LDS_BYTES, stream, a);
        const int j = (st == 0) ? 10 : (st == NSTEPS - 1 ? 11 : (st - 1) % NPH);
#ifndef DUP_PROBE
#define DUP_PROBE 0
#endif
        if ((DUP_MASK >> j) & 1) { a.probe = DUP_PROBE; hipLaunchKernelGGL(mk_fwd_t<DUP_PROBE>, dim3(grid), dim3(NWAVES * 64), LDS_BYTES, stream, a); a.probe = 0; } }
#else
    a.ph_lo = 0; a.ph_hi = NSTEPS;
    hipLaunchKernelGGL(mk_fwd, dim3(grid), dim3(NWAVES * 64), LDS_BYTES, stream, a);
#endif
    const hipError_t le = hipPeekAtLastError();
    if (le != hipSuccess) fprintf(stderr, "kernel_launch: launch failed: %s\n", hipGetErrorName(le));
}
```

```cpp
#include <hip/hip_runtime.h>
#include <cstdio>
#include <cstdint>
#ifndef MK_MULTI
#define MK_MULTI 0
#endif
#ifndef MK_CHECK
#define MK_CHECK 0
#endif
namespace pg8 {
#define PG8_LAS __attribute__((address_space(3)))
typedef unsigned short bf16_t;
typedef short bf16x8 __attribute__((ext_vector_type(8)));
typedef float f32x4 __attribute__((ext_vector_type(4)));
typedef unsigned u32x4 __attribute__((ext_vector_type(4)));
constexpr int BM = 256, BK = 64, HALF = 128, HTB = HALF * BK * 2  , STAGE_BYTES = 8 * HTB, NXCD = 8, WGM = 8;

__host__ __device__ __forceinline__ int lds_byte(int r, int c) { const int st = (r >> 4) * 2 + (c >> 5), rr = r & 15, cc = c & 31, ob = rr * 64 + cc * 2; return st * 1024 + (ob ^ (((ob >> 9) & 1) << 5)); }
__host__ __device__ __forceinline__ void stage_rc(int b, int& R, int& C) { const int st = b / 1024, sb = b % 1024, swz = sb ^ (((sb >> 9) & 1) << 5); R = (st >> 1) * 16 + swz / 64; C = (st & 1) * 32 + (swz % 64) / 2; }
__host__ __device__ __forceinline__ int perm32(int rho) { const int n = rho >> 4, i = rho & 15; return 8 * (i >> 2) + 4 * n + (i & 3); }

struct Unit { int pm, pn; };
struct Gemm { const bf16_t* A; const bf16_t* Bt; int M, N, K; };

struct StaticOrder {
    int nM, nN, nwg, G, c;
    __host__ __device__ void init(int M, int N, int G_, int c_) { nM = M / BM; nN = N / BM; nwg = nM * nN; G = G_; c = c_; }
    __host__ __device__ bool next(int i, Unit& u) const {
        const long L = (long)i * G + c; if (L >= nwg) return false;
        int wgid = (int)L; { const int q = nwg / NXCD, r = nwg % NXCD, xcd = wgid % NXCD, off = wgid / NXCD; wgid = (xcd < r ? xcd * (q + 1) : r * (q + 1) + (xcd - r) * q) + off; }
        const int nig = WGM * nN, gid = wgid / nig, fm = gid * WGM, gsz = (nM - fm) < WGM ? (nM - fm) : WGM;
        u.pm = fm + ((wgid % nig) % gsz); u.pn = (wgid % nig) / gsz; return true;
    }
    __device__ __forceinline__ void a_ready(const Unit&) const {}
    __device__ __forceinline__ void done(const Unit&) const {}
};
__device__ __forceinline__ unsigned cvt_pk_bf16(float lo, float hi) { unsigned r; asm volatile("v_cvt_pk_bf16_f32 %0, %1, %2" : "=v"(r) : "v"(lo), "v"(hi)); return r; }
typedef int v8i_t __attribute__((ext_vector_type(8)));
typedef int v4i_t __attribute__((ext_vector_type(4)));
__device__ __forceinline__ f32x4 mfma8(bf16x8 b0, bf16x8 b1, bf16x8 a0, bf16x8 a1, f32x4 c) {
    const v8i_t B = __builtin_shufflevector(__builtin_bit_cast(v4i_t, b0), __builtin_bit_cast(v4i_t, b1), 0, 1, 2, 3, 4, 5, 6, 7);
    const v8i_t A = __builtin_shufflevector(__builtin_bit_cast(v4i_t, a0), __builtin_bit_cast(v4i_t, a1), 0, 1, 2, 3, 4, 5, 6, 7);
#if defined(MFMA8_BUILTIN)
    return __builtin_amdgcn_mfma_scale_f32_16x16x128_f8f6f4(B, A, c, 0, 0, 0, 0x7F7F7F7F, 0, 0x7F7F7F7F);
#else
    const int one = 0x7F7F7F7F;
    asm volatile("s_nop 1\n\tv_mfma_scale_f32_16x16x128_f8f6f4 %0, %1, %2, %0, %3, %3 op_sel_hi:[0,0,0]" : "+v"(c) : "v"(B), "v"(A), "v"(one));
    return c;
#endif
}
template <class Epi, class Sched, bool ALIGN_EPI = false, bool SP2 = false, bool FP8 = false, bool GATHER = false>
__device__ __forceinline__ void gemm_phase(PG8_LAS unsigned char* lds, const Gemm g, const Sched& S, const Epi& E, int tid_in) {
    int tid_l = tid_in; asm volatile("" : "+v"(tid_l));
    const int tid = tid_l, wid = __builtin_amdgcn_readfirstlane(tid >> 6), lane = tid & 63, wr = wid >> 2, wc = wid & 3, fr = lane & 15, fq = lane >> 4;
    const int K = g.K, nt = K / BK;
    unsigned voffA[2], voffB[2], voffB1[2];
#pragma unroll
    for (int i = 0; i < 2; ++i) { int R, C; stage_rc(tid * 16 + i * 8192, R, C); const int Rb = Epi::PERM ? ((R & ~31) + perm32(R & 31)) : R;
        voffA[i] = (unsigned)(R * K + C) * 2u; voffB[i] = (unsigned)(Rb * K + C) * 2u; voffB1[i] = 0u;
        if constexpr (Epi::PERM16) { const int rho = R & 31, ii = rho & 15, R16 = 64 * (R >> 5) + 16 * (ii >> 2) + 4 * (rho >> 4) + (ii & 3); voffB[i] = (unsigned)(R16 * K + C) * 2u; voffB1[i] = (unsigned)((R16 + 8) * K + C) * 2u; } }
    static_assert(!GATHER || SP2, "GATHER is implemented for the SP2 loop only");
    unsigned gA[2], gN[2];
    int gR0, gC0; stage_rc(tid * 16, gR0, gC0);
    const unsigned gc2 = (unsigned)gC0 * 2u, gpitch = (unsigned)K * 2u;
#define PG8_GROWS(dst, U) do { if constexpr (GATHER) { int _t = tid; asm volatile("" : "+v"(_t)); int _R, _C; stage_rc(_t * 16, _R, _C);   \
        _Pragma("unroll") for (int _h = 0; _h < 2; ++_h) dst[_h] = (unsigned)S.arow(U, _h * HALF + _R) | ((unsigned)S.arow(U, _h * HALF + _R + 64) << 16); } } while (0)
#define PG8_GCOPY(dst, src) do { if constexpr (GATHER) { dst[0] = src[0]; dst[1] = src[1]; } } while (0)
    const size_t kstep = (size_t)(BK * 2);
    const size_t hstep = (size_t)HALF * K * 2;
    const size_t tstep = 2 * hstep;
    const unsigned ldsw = (unsigned)wid * 1024u;
    const int aoff = lds_byte(wr * 64 + fr, fq * 8), boff = lds_byte(wc * 32 + fr, fq * 8);
#define PG8_SA(b, h) (((b) * 2 + (h)) * HTB)
#define PG8_SB(b, h) ((4 + (b) * 2 + (h)) * HTB)
#define PG8_STAGE(bufoff, gbase, voff) do { _Pragma("unroll") for (int _i = 0; _i < 2; ++_i) \
        __builtin_amdgcn_global_load_lds((const unsigned*)((const char*)(gbase) + (voff)[_i]), (PG8_LAS unsigned*)(lds + (bufoff) + ldsw + _i * 8192), 16, 0, 0); } while (0)
#define PG8_STAGE_A(bufoff, gbase, half, usenext) do { if constexpr (GATHER) { const unsigned _pk = (usenext) ? gN[half] : gA[half]; unsigned _v[2]; _v[0] = (_pk & 0xffffu) * gpitch + gc2; _v[1] = (_pk >> 16) * gpitch + gc2; PG8_STAGE(bufoff, gbase, _v); } \
        else { PG8_STAGE(bufoff, (gbase) + ((half) ? hstep : 0), voffA); } } while (0)
#define PG8_STAGE_B1(bufoff, gbase) do { if constexpr (Epi::PERM16) { PG8_STAGE(bufoff, gbase, voffB1); } else { PG8_STAGE(bufoff, (gbase) + hstep, voffB); } } while (0)
#define PG8_LDA(dst, b, h) do { _Pragma("unroll") for (int m = 0; m < 4; ++m) _Pragma("unroll") for (int k = 0; k < 2; ++k) dst[m][k] = *(const PG8_LAS bf16x8*)(lds + PG8_SA(b, h) + aoff + m * 2048 + k * 1024); } while (0)
#define PG8_LDB(dst, b, h) do { _Pragma("unroll") for (int n = 0; n < 2; ++n) _Pragma("unroll") for (int k = 0; k < 2; ++k) dst[n][k] = *(const PG8_LAS bf16x8*)(lds + PG8_SB(b, h) + boff + n * 2048 + k * 1024); } while (0)
#define PG8_MMA(ai, bj, At, Bt) do { __builtin_amdgcn_s_setprio(1); _Pragma("unroll") for (int m = 0; m < 4; ++m) _Pragma("unroll") for (int n = 0; n < 2; ++n) { \
        if constexpr (FP8) { acc[ai][bj][m][n] = mfma8(Bt[n][0], Bt[n][1], At[m][0], At[m][1], acc[ai][bj][m][n]); } \
        else { _Pragma("unroll") for (int k = 0; k < 2; ++k) acc[ai][bj][m][n] = __builtin_amdgcn_mfma_f32_16x16x32_bf16(Bt[n][k], At[m][k], acc[ai][bj][m][n], 0, 0, 0); } } __builtin_amdgcn_s_setprio(0); } while (0)
#define PG8_ZERO(ai) do { _Pragma("unroll") for (int _b = 0; _b < 2; ++_b) _Pragma("unroll") for (int _m = 0; _m < 4; ++_m) _Pragma("unroll") for (int _n = 0; _n < 2; ++_n) acc[ai][_b][_m][_n] = (f32x4){0.f, 0.f, 0.f, 0.f}; } while (0)
#define PG8_WAIT_V(n) asm volatile("s_waitcnt vmcnt(" #n ")" ::: "memory")
#define PG8_WAIT_VF do { if (fst) asm volatile("s_waitcnt vmcnt(%0)" :: "n"(8 + Epi::NVM) : "memory"); else asm volatile("s_waitcnt vmcnt(8)" ::: "memory"); } while (0)
#define PG8_WAIT_L(n) asm volatile("s_waitcnt lgkmcnt(" #n ")" ::: "memory")
#define PG8_BAR __builtin_amdgcn_s_barrier()
#define PG8_SCHED __builtin_amdgcn_sched_barrier(0)
    Unit cur, nxt; int ui = 0;
    if (!S.next(0, cur)) return;
    f32x4 acc[2][2][4][2];
#pragma unroll
    for (int a = 0; a < 2; ++a)
#pragma unroll
        for (int b = 0; b < 2; ++b)
#pragma unroll
            for (int m = 0; m < 4; ++m)
#pragma unroll
                for (int n = 0; n < 2; ++n) acc[a][b][m][n] = (f32x4){0.f, 0.f, 0.f, 0.f};
    bf16x8 At[4][2], B0[2][2], B1[2][2];
    const char* cA = GATHER ? (const char*)g.A : (const char*)g.A + (size_t)cur.pm * tstep; const char* cB = (const char*)g.Bt + (size_t)cur.pn * tstep;
    S.a_ready(cur);
    if constexpr (GATHER) { PG8_GROWS(gA, cur);
        Unit u1; if (S.next(1, u1)) { PG8_GROWS(gN, u1); } else { PG8_GCOPY(gN, gA); } }
    if constexpr (SP2) {
        PG8_STAGE(PG8_SB(0, 0), cB, voffB); PG8_STAGE_B1(PG8_SB(0, 1), cB); PG8_STAGE_A(PG8_SA(0, 0), cA, 0, false); PG8_STAGE_A(PG8_SA(0, 1), cA, 1, false);
        if (wr == 1) PG8_BAR;
        PG8_WAIT_V(2); PG8_BAR;
        PG8_STAGE(PG8_SB(1, 0), cB + kstep, voffB); PG8_STAGE_A(PG8_SA(1, 0), cA + kstep, 0, false); PG8_STAGE_B1(PG8_SB(1, 1), cB + kstep);
        PG8_WAIT_V(6); PG8_BAR;
    } else {
        PG8_STAGE(PG8_SB(0, 0), cB, voffB); PG8_STAGE(PG8_SA(0, 0), cA, voffA); PG8_STAGE_B1(PG8_SB(0, 1), cB); PG8_STAGE(PG8_SA(0, 1), cA + hstep, voffA);
        if (wr == 1) PG8_BAR;
        PG8_WAIT_V(4); PG8_BAR;
        PG8_STAGE(PG8_SB(1, 0), cB + kstep, voffB); PG8_STAGE(PG8_SA(1, 0), cA + kstep, voffA); PG8_STAGE_B1(PG8_SB(1, 1), cB + kstep);
        PG8_WAIT_V(6); PG8_BAR;
    }
    for (;;) {
        const bool has_next = S.next(ui + 1, nxt);
        const char* nA = (has_next && !GATHER) ? (const char*)g.A + (size_t)nxt.pm * tstep : cA; const char* nB = has_next ? (const char*)g.Bt + (size_t)nxt.pn * tstep : cB;
        PG8_LAS unsigned char* const pre = lds + STAGE_BYTES + wid * 2048;
#pragma unroll 1
        for (int t = 0; t < nt; t += 2) {
            const bool last = (t == nt - 2);
            const bool fst = SP2 && Epi::NVM > 0 && t == 0 && ui > 0;
            if (last) E.prefetch(pre, cur, wr, wc, fr, fq);
            const char* a1 = cA + (size_t)(t + 1) * kstep;
            const char* a2 = last ? nA : cA + (size_t)(t + 2) * kstep; const char* b2 = last ? nB : cB + (size_t)(t + 2) * kstep;
            const char* a3 = a2 + kstep; const char* b3 = b2 + kstep;
            if (last && has_next) S.a_ready(nxt);
            if constexpr (SP2) {
            PG8_LDB(B0, 0, 0); PG8_LDB(B1, 0, 1); PG8_SCHED; PG8_LDA(At, 0, 0); if (!fst) { PG8_STAGE_A(PG8_SA(1, 1), a1, 1, false); }
            if (t == 0 && ui > 0) { PG8_ZERO(0); PG8_SCHED; }
            PG8_WAIT_VF; PG8_WAIT_L(0); PG8_BAR; PG8_MMA(0, 0, At, B0); PG8_MMA(0, 1, At, B1); PG8_BAR; PG8_SCHED;
            PG8_LDA(At, 0, 1); PG8_STAGE(PG8_SB(0, 0), b2, voffB); PG8_STAGE_B1(PG8_SB(0, 1), b2); PG8_STAGE_A(PG8_SA(0, 0), a2, 0, last);
            if (t == 0 && ui > 0) { PG8_ZERO(1); PG8_SCHED; }
            PG8_WAIT_VF; PG8_WAIT_L(0); PG8_BAR; PG8_MMA(1, 0, At, B0); PG8_MMA(1, 1, At, B1); PG8_BAR; PG8_SCHED;
            PG8_LDB(B0, 1, 0); PG8_LDB(B1, 1, 1); PG8_SCHED; PG8_LDA(At, 1, 0); PG8_STAGE_A(PG8_SA(0, 1), a2, 1, last);
            PG8_WAIT_VF; PG8_WAIT_L(0); PG8_BAR; PG8_MMA(0, 0, At, B0); PG8_MMA(0, 1, At, B1); PG8_BAR; PG8_SCHED;
            PG8_LDA(At, 1, 1); PG8_STAGE(PG8_SB(1, 0), b3, voffB); PG8_STAGE_B1(PG8_SB(1, 1), b3); PG8_STAGE_A(PG8_SA(1, 0), a3, 0, last);
            PG8_WAIT_V(8); PG8_WAIT_L(0); PG8_BAR; PG8_MMA(1, 0, At, B0); PG8_MMA(1, 1, At, B1); PG8_BAR; PG8_SCHED;
            } else {
            PG8_LDB(B0, 0, 0); PG8_SCHED; PG8_LDA(At, 0, 0); PG8_STAGE(PG8_SA(1, 1), a1 + hstep, voffA);
            PG8_WAIT_L(8); PG8_BAR; PG8_WAIT_L(0); PG8_MMA(0, 0, At, B0); PG8_BAR; PG8_SCHED;
            PG8_LDB(B1, 0, 1); PG8_STAGE(PG8_SB(0, 0), b2, voffB);
            PG8_BAR; PG8_WAIT_L(0); PG8_MMA(0, 1, At, B1); PG8_BAR;
            PG8_LDA(At, 0, 1); PG8_STAGE(PG8_SA(0, 0), a2, voffA);
            PG8_BAR; PG8_WAIT_L(0); PG8_MMA(1, 0, At, B0); PG8_BAR; PG8_SCHED;
            PG8_STAGE_B1(PG8_SB(0, 1), b2);
            PG8_WAIT_V(6); PG8_BAR; PG8_MMA(1, 1, At, B1); PG8_BAR;
            PG8_LDB(B0, 1, 0); PG8_SCHED; PG8_LDA(At, 1, 0); PG8_STAGE(PG8_SA(0, 1), a2 + hstep, voffA);
            PG8_WAIT_L(8); PG8_BAR; PG8_WAIT_L(0); PG8_MMA(0, 0, At, B0); PG8_BAR; PG8_SCHED;
            PG8_LDB(B1, 1, 1); PG8_STAGE(PG8_SB(1, 0), b3, voffB);
            PG8_BAR; PG8_WAIT_L(0); PG8_MMA(0, 1, At, B1); PG8_BAR;
            PG8_LDA(At, 1, 1); PG8_STAGE(PG8_SA(1, 0), a3, voffA);
            PG8_BAR; PG8_WAIT_L(0); PG8_MMA(1, 0, At, B0); PG8_BAR; PG8_SCHED;
            PG8_STAGE_B1(PG8_SB(1, 1), b3);
            PG8_WAIT_V(6); PG8_BAR; PG8_MMA(1, 1, At, B1); PG8_BAR;
            }
        }
        if constexpr (SP2 && Epi::NVM > 0) { if (has_next) { PG8_STAGE_A(PG8_SA(1, 1), nA + kstep, 1, true); } }
        if constexpr (FP8) {
#pragma unroll
            for (int a = 0; a < 2; ++a)
#pragma unroll
                for (int b = 0; b < 2; ++b) {
                    if (a == 0 && b == 0) asm volatile("s_nop 15\n\ts_nop 15\n\ts_nop 15\n\ts_nop 15\n\ts_nop 7" : "+v"(acc[a][b][0][0]), "+v"(acc[a][b][0][1]), "+v"(acc[a][b][1][0]), "+v"(acc[a][b][1][1]), "+v"(acc[a][b][2][0]), "+v"(acc[a][b][2][1]), "+v"(acc[a][b][3][0]), "+v"(acc[a][b][3][1]));
                    else asm volatile("" : "+v"(acc[a][b][0][0]), "+v"(acc[a][b][0][1]), "+v"(acc[a][b][1][0]), "+v"(acc[a][b][1][1]), "+v"(acc[a][b][2][0]), "+v"(acc[a][b][2][1]), "+v"(acc[a][b][3][0]), "+v"(acc[a][b][3][1])); }
        }
        Unit nx2; bool has2 = false;
        int tkr[2][2];
        if constexpr (GATHER) { has2 = has_next && S.next(ui + 2, nx2); if (has2) { int _t = tid; asm volatile("" : "+v"(_t)); int _R, _C; stage_rc(_t * 16, _R, _C);
#pragma unroll
            for (int _h = 0; _h < 2; ++_h) { tkr[_h][0] = S.arow(nx2, _h * HALF + _R); tkr[_h][1] = S.arow(nx2, _h * HALF + _R + 64); } } }
        if constexpr (ALIGN_EPI) { if (wr == 0) PG8_BAR; }
        if constexpr (!Epi::AFTER_DRAIN) { E(acc, cur, wr, wc, fr, fq, pre); S.done(cur); }
        if (!has_next) break;
        cur = nxt; cA = nA; cB = nB; ++ui;
        if constexpr (GATHER) { PG8_GCOPY(gA, gN); if (has2) { gN[0] = (unsigned)tkr[0][0] | ((unsigned)tkr[0][1] << 16); gN[1] = (unsigned)tkr[1][0] | ((unsigned)tkr[1][1] << 16); } }
        if constexpr (ALIGN_EPI) { if (wr == 1) PG8_BAR; }
    }
    PG8_WAIT_V(0);
    if constexpr (!ALIGN_EPI) { if (wr == 0) PG8_BAR; }
    PG8_BAR;
    if constexpr (Epi::AFTER_DRAIN) { E.fused(acc, cur, wr, wc, fr, fq, lds, wid, lane); S.done(cur); }
#undef PG8_SA
#undef PG8_STAGE_A
#undef PG8_STAGE_B1
#undef PG8_GROWS
#undef PG8_GCOPY
#undef PG8_SB
#undef PG8_STAGE
#undef PG8_LDA
#undef PG8_LDB
#undef PG8_MMA
#undef PG8_WAIT_V
#undef PG8_ZERO
#undef PG8_WAIT_L
#undef PG8_WAIT_VF
#undef PG8_BAR
#undef PG8_SCHED
}
}
constexpr int D = 1024, NB = 4, SEQ = 8192, TL = NB * SEQ, LC = 256, TCX = NB * LC, TT = TL + TCX;
constexpr int DEPTH = 4, NH = 4, DK = 128, DV = 256, QKW = 512, RWD = 1024, CWD = 512, MIXW = 1536, INW = 4608;
constexpr int NE = 32, TOPK = 4, DFF = 1024, NCH = 66;
constexpr int RMAX = TT * TOPK + NE * 256;
constexpr float EPS = 1e-6f;
constexpr int NWAVES = 8;

constexpr size_t MiB = 1u << 20;
constexpr size_t WS_CTL = 0, CTL_ZERO_BYTES = 1 * MiB;
constexpr size_t WS_MODV = 1 * MiB;
constexpr size_t WS_ROPE = 2 * MiB;
constexpr size_t WS_G1H = 2 * MiB + 64 * 1024;
constexpr size_t WS_BUPH = 2 * MiB + 256 * 1024, WS_BDNH = 2 * MiB + 768 * 1024;
constexpr size_t WS_RWHL = 3 * MiB;
constexpr size_t WS_WINT = 4 * MiB;
constexpr size_t WS_WOUTT = 40 * MiB;
constexpr size_t WS_WUPT = 64 * MiB;
constexpr size_t WS_WDNT = 576 * MiB;
constexpr size_t WS_X = 832 * MiB;
constexpr size_t WS_HB = 964 * MiB;
constexpr size_t WS_QB = 1032 * MiB, WS_KB = 1066 * MiB, WS_VB = 1100 * MiB, WS_GB = 1168 * MiB, WS_CBB = 1236 * MiB, WS_CCB = 1270 * MiB, WS_CXB = 1304 * MiB;
constexpr size_t WS_KVF = 1338 * MiB, WS_KVB = 1404 * MiB;
constexpr size_t WS_MIX = 1470 * MiB;
constexpr size_t WS_ASG = 1570 * MiB;
constexpr size_t WS_XG = 1576 * MiB, WS_ACT = 1856 * MiB, WS_YB = 2136 * MiB;
constexpr size_t WS_TLIST = WS_XG;
constexpr size_t WS_HB8 = WS_XG + 144 * MiB;
constexpr size_t WS_XB = 2416 * MiB;
constexpr size_t WS_SF = 2548 * MiB, WS_SB = 2614 * MiB, WS_END = 2680 * MiB;
static_assert((size_t)RMAX * 1024 * 2 <= 280 * MiB && (size_t)TT * 1536 * 2 <= 100 * MiB && (size_t)16 * 66 * 32768 * 2 <= 66 * MiB, "ws map");
constexpr int CW_ERR = 1, CW_BAR = 4096, CW_GCNT = 16384;

constexpr int PH_LDS = 155648;
constexpr int MISC_OFF = PH_LDS, LDS_BYTES = PH_LDS + 2048;
constexpr int RPITCH = 272;

#define GAS __attribute__((address_space(1)))
#define LAS __attribute__((address_space(3)))
typedef unsigned short bf16;
typedef unsigned v4u __attribute__((ext_vector_type(4)));
typedef unsigned v2u __attribute__((ext_vector_type(2)));
typedef float f32x4 __attribute__((ext_vector_type(4)));
typedef short bf16x8 __attribute__((ext_vector_type(8)));
typedef short s16x4 __attribute__((ext_vector_type(4)));
#define LDS_WAIT() asm volatile("s_waitcnt lgkmcnt(0)" ::: "memory")
#define VM_WAIT() asm volatile("s_waitcnt vmcnt(0)" ::: "memory")
__device__ __forceinline__ unsigned f2bf(float f) { unsigned u = __builtin_bit_cast(unsigned, f); return (u + 0x7fffu + ((u >> 16) & 1u)) >> 16; }
typedef float f32x2_t __attribute__((ext_vector_type(2)));
typedef __bf16 bf16x2_t __attribute__((ext_vector_type(2)));
__device__ __forceinline__ unsigned pk2(float lo, float hi) { const f32x2_t v = {lo, hi}; return __builtin_bit_cast(unsigned, __builtin_convertvector(v, bf16x2_t)); }
__device__ __forceinline__ float bflo(unsigned w) { return __builtin_bit_cast(float, w << 16); }
__device__ __forceinline__ float bfhi(unsigned w) { return __builtin_bit_cast(float, w & 0xffff0000u); }
__device__ __forceinline__ v2u pk8_fp8(const float (&f)[8]) {
    int w0 = __builtin_amdgcn_cvt_pk_fp8_f32(f[0], f[1], 0, false); w0 = __builtin_amdgcn_cvt_pk_fp8_f32(f[2], f[3], w0, true);
    int w1 = __builtin_amdgcn_cvt_pk_fp8_f32(f[4], f[5], 0, false); w1 = __builtin_amdgcn_cvt_pk_fp8_f32(f[6], f[7], w1, true);
    v2u o; o.x = (unsigned)w0; o.y = (unsigned)w1; return o;
}
__device__ __forceinline__ float bf2f(bf16 b) { return __builtin_bit_cast(float, ((unsigned)b) << 16); }
__device__ __forceinline__ float logsig(float x) { return -log1pf(expf(-x)); }
__device__ __forceinline__ float fexp(float x) { return __builtin_amdgcn_exp2f(x * 1.44269504088896f); }
__device__ __forceinline__ float fsigm(float x) { return __builtin_amdgcn_rcpf(1.f + fexp(-x)); }
__device__ __forceinline__ int shx_i(int v, int o, int lane) { return __builtin_amdgcn_ds_bpermute((lane ^ o) << 2, v); }
__device__ __forceinline__ float shx_f(float v, int o, int lane) { return __builtin_bit_cast(float, __builtin_amdgcn_ds_bpermute((lane ^ o) << 2, __builtin_bit_cast(int, v))); }
__device__ __forceinline__ int shl_i(int v, int src) { return __builtin_amdgcn_ds_bpermute(src << 2, v); }
__device__ __forceinline__ float shl_f(float v, int src) { return __builtin_bit_cast(float, __builtin_amdgcn_ds_bpermute(src << 2, __builtin_bit_cast(int, v))); }
__device__ __forceinline__ float wave_sum(float v, int lane) {
#pragma unroll
    for (int o = 1; o < 64; o <<= 1) v += shx_f(v, o, lane);
    return v;
}

#define XB_TMO      128
#define XB_XCNT(j)  (256  + 64 * (j))
#define XB_XSUB(j)  (1280 + 64 * (j))
#define XB_XGEN(j)  (2304 + 64 * (j))
#define XB_TOP      3328
#define XB_TOPGEN   3392
#define XCD_BAR_WORDS 3456
#define XB_SPIN_CAP (1u << 18)

__device__ __forceinline__ unsigned xb_ld(unsigned* p)              { return __hip_atomic_load(p, __ATOMIC_RELAXED, __HIP_MEMORY_SCOPE_AGENT); }
__device__ __forceinline__ unsigned xb_add(unsigned* p, unsigned v) { return __hip_atomic_fetch_add(p, v, __ATOMIC_RELAXED, __HIP_MEMORY_SCOPE_AGENT); }
__device__ __forceinline__ unsigned xb_xcc_id() { return (unsigned)__builtin_amdgcn_s_getreg((3 << 11) | 20) & 0xFu; }
#define XB_SPIN(cond, bar) do { unsigned _sp = 0; while (cond) { __builtin_amdgcn_s_sleep(1); \
    if ((++_sp & 255u) == 0u) { if (xb_ld(&(bar)[XB_TMO])) break; if (_sp > XB_SPIN_CAP) { atomicAdd(&(bar)[XB_TMO], 1u); break; } } } } while (0)

struct XcdBarrier {
    unsigned* bar; unsigned x;
    volatile LAS unsigned* st;
};

__device__ __forceinline__ XcdBarrier xcd_barrier_post(unsigned* bar, volatile LAS unsigned* st) {
    XcdBarrier b; b.bar = bar; b.x = xb_xcc_id(); b.st = st;
    if (threadIdx.x == 0) (void)xb_add(&bar[XB_XCNT(b.x)], 1u);
    return b;
}
__device__ __forceinline__ void xcd_barrier_complete(unsigned* bar, unsigned x, unsigned& nloc, unsigned& nx) {
    const unsigned G = gridDim.x * gridDim.y * gridDim.z;
    unsigned sum, cnt, mine, sp = 0u;
    for (;;) {
        sum = 0u; cnt = 0u; mine = 0u;
#pragma unroll
        for (unsigned j = 0; j < 16; ++j) { const unsigned c = xb_ld(&bar[XB_XCNT(j)]); sum += c; cnt += (c > 0u) ? 1u : 0u; mine = (j == x) ? c : mine; }
        if (sum == G) break;
        __builtin_amdgcn_s_sleep(1);
        if ((++sp & 255u) == 0u) { if (xb_ld(&bar[XB_TMO])) break; if (sp > XB_SPIN_CAP) { atomicAdd(&bar[XB_TMO], 1u); break; } }
    }
    nloc = mine > 0u ? mine : 1u; nx = cnt > 0u ? cnt : 1u;
}

__device__ __forceinline__ void xcd_barrier(const XcdBarrier& b) {
    asm volatile("s_waitcnt vmcnt(0)" ::: "memory");
    __syncthreads();
    if (threadIdx.x == 0) {
        unsigned* bar = b.bar;
        __builtin_amdgcn_s_waitcnt(0);
        unsigned nloc = b.st[0], nx = b.st[1];
        if (nloc == 0u) { xcd_barrier_complete(bar, b.x, nloc, nx); b.st[0] = nloc; b.st[1] = nx; }
        const unsigned old = xb_add(&bar[XB_XSUB(b.x)], 1u);
        const unsigned gen = old / nloc;
        if (old + 1u == (gen + 1u) * nloc) {
            __builtin_amdgcn_fence(__ATOMIC_RELEASE, "agent");
            asm volatile("s_waitcnt vmcnt(0)" ::: "memory");
            const unsigned og = xb_add(&bar[XB_TOP], 1u);
            const unsigned tg = og / nx;
            if (og + 1u == (tg + 1u) * nx) xb_add(&bar[XB_TOPGEN], 1u);
            else XB_SPIN(xb_ld(&bar[XB_TOPGEN]) == tg, bar);
            __builtin_amdgcn_fence(__ATOMIC_ACQUIRE, "agent");
            xb_add(&bar[XB_XGEN(b.x)], 1u);
            asm volatile("s_waitcnt vmcnt(0)" ::: "memory");
        } else {
            XB_SPIN(xb_ld(&bar[XB_XGEN(b.x)]) == gen, bar);
            __builtin_amdgcn_fence(__ATOMIC_ACQUIRE, "agent");
            asm volatile("s_waitcnt vmcnt(0)" ::: "memory");
        }
    }
    __syncthreads();
}

struct Args { const float* in[20]; float* out; unsigned char* ws; int ph_lo, ph_hi, probe, pad; };
#define CAS __attribute__((address_space(4)))
struct Frame {
    LAS unsigned char* lds;
    unsigned* ctl;
    int tid, lane, wave, G, bid;
    const CAS Args* ka; float* out; unsigned char* ws;
};
#define MKFRAME(F) Frame F; { int t_; asm volatile("v_mbcnt_lo_u32_b32 %0, -1, 0\n\tv_mbcnt_hi_u32_b32 %0, -1, %0\n\tv_lshl_or_b32 %0, %1, 6, %0" : "=&v"(t_) : "s"(wave0));     \
    F.tid = t_; F.lane = t_ & 63; F.wave = __builtin_amdgcn_readfirstlane(t_ >> 6); \
    const CAS Args* ka_ = (const CAS Args*)__builtin_amdgcn_kernarg_segment_ptr(); asm volatile("" : "+s"(ka_)); F.ka = ka_; F.ws = ka_->ws; F.out = ka_->out; F.ctl = (unsigned*)ka_->ws; \
    F.lds = (LAS unsigned char*)lds; F.G = gridDim.x; F.bid = blockIdx.x; }
#define IN_(i) (F.ka->in[i])
#define WSP(T, off) ((T*)(F.ws + (off)))

__device__ __forceinline__ void p0_mod(Frame& F) {
    LAS float* sv = (LAS float*)(F.lds);
    LAS float* red = (LAS float*)(F.lds + 20480);
    float* MODV = WSP(float, WS_MODV);
    bool filled = false;
    for (int s = F.bid; s < DEPTH * 48; s += F.G) {
        if (!filled) {
            for (int i = F.tid; i < 5 * 1024; i += 512) { const int si = i >> 10, k = i & 1023; const float c = si < 4 ? IN_(1)[si * 1024 + k] : IN_(3)[k]; sv[i] = c / (1.f + expf(-c)); }
            __syncthreads(); filled = true;
        }
        const int l = s / 48, col0 = (s % 48) * 128, kg = F.tid >> 7, j = F.tid & 127;
        const float* w = IN_(4) + (size_t)l * 1024 * 6144 + col0 + j;
        float a0 = 0.f, a1 = 0.f, a2 = 0.f, a3 = 0.f, a4 = 0.f;
#pragma unroll 8
        for (int k = kg * 256; k < kg * 256 + 256; ++k) { const float wv = w[(size_t)k * 6144]; a0 += sv[k] * wv; a1 += sv[1024 + k] * wv; a2 += sv[2048 + k] * wv; a3 += sv[3072 + k] * wv; a4 += sv[4096 + k] * wv; }
        red[(kg * 5 + 0) * 128 + j] = a0; red[(kg * 5 + 1) * 128 + j] = a1; red[(kg * 5 + 2) * 128 + j] = a2; red[(kg * 5 + 3) * 128 + j] = a3; red[(kg * 5 + 4) * 128 + j] = a4;
        __syncthreads();
        if (F.tid < 128) {
            const float bias = IN_(5)[l * 6144 + col0 + j];
#pragma unroll
            for (int s5 = 0; s5 < 5; ++s5) { const float t = ((red[(0 * 5 + s5) * 128 + j] + red[(1 * 5 + s5) * 128 + j]) + red[(2 * 5 + s5) * 128 + j]) + red[(3 * 5 + s5) * 128 + j];
                MODV[(size_t)(l * 5 + s5) * 6144 + col0 + j] = t + bias;
                if (col0 >= 2048 && col0 < 3072) WSP(bf16, WS_G1H)[(size_t)(l * 5 + s5) * 1024 + col0 - 2048 + j] = (bf16)f2bf((t + bias) * 0.03125f); }
        }
        __syncthreads();
    }
}
template <int MAP> __device__ __forceinline__ int rowmap(int n) {
    if (MAP == 1) { if (n < 1024) return (n & ~63) | ((n & 31) << 1) | ((n >> 5) & 1);
        if (n >= 3584) { const int j = (n - 3584) & 511; return 3584 + ((j >> 7) << 8) + (n >= 4096 ? 128 : 0) + (j & 127); }
        return n; }
    if (MAP == 2) return n < 1024 ? (((n >> 7) << 8) | (n & 127)) : ((((n - 1024) >> 7) << 8) | 128 | ((n - 1024) & 127));
    return n;
}
constexpr int I_IN = 16 * 72, I_OUT = 24 * 16, I_UP = 32 * 16 * 32, I_DN = 32 * 16 * 16, I_L = I_IN + I_OUT + I_UP + I_DN;
constexpr int CW_QCONV = 12288;
constexpr int CVT_BATCH = 4;
constexpr int CVT_P = 65;
struct CvtItem { const float* W; unsigned char* WT; int N, K, k0, n0, kind; };
__device__ __forceinline__ void cvt_desc(Frame& F, int l, int r, CvtItem& d) {
    if (r < I_IN) { d.W = IN_(8) + (size_t)l * 1024 * INW; d.K = 1024; d.N = INW; d.WT = (unsigned char*)(WSP(bf16, WS_WINT) + (size_t)l * INW * 1024); d.kind = 0; d.k0 = 64 * (r / 72); d.n0 = 64 * (r % 72); return; } r -= I_IN;
    if (r < I_OUT) { d.W = IN_(12) + (size_t)l * MIXW * 1024; d.K = MIXW; d.N = 1024; d.WT = WSP(unsigned char, WS_WOUTT) + (size_t)l * 1024 * MIXW; d.kind = 1; d.k0 = 64 * (r >> 4); d.n0 = 64 * (r & 15); return; } r -= I_OUT;
    if (r < I_UP) { const int e = r >> 9, it = r & 511; d.W = IN_(15) + (size_t)(l * NE + e) * 1024 * 2048; d.K = 1024; d.N = 2048; d.WT = WSP(unsigned char, WS_WUPT) + (size_t)(l * NE + e) * 2048 * 1024; d.kind = 2; d.k0 = 64 * (it >> 5); d.n0 = 64 * (it & 31); return; } r -= I_UP;
    { const int e = r >> 8, it = r & 255; d.W = IN_(17) + (size_t)(l * NE + e) * 1024 * 1024; d.K = 1024; d.N = 1024; d.WT = WSP(unsigned char, WS_WDNT) + (size_t)(l * NE + e) * 1024 * 1024; d.kind = 1; d.k0 = 64 * (it >> 4); d.n0 = 64 * (it & 15); }
}
__device__ __forceinline__ void convert_item(Frame& F, int l, int r) {
    LAS float* scr = (LAS float*)(F.lds + F.wave * 16896);
    CvtItem d; cvt_desc(F, l, r, d);
    const int lane = F.lane, r2 = lane >> 4, n4 = (lane & 15) * 4;
    f32x4 wv[16];
#pragma unroll
    for (int i = 0; i < 16; ++i) wv[i] = *(const f32x4*)(d.W + (size_t)(d.k0 + 4 * i + r2) * d.N + d.n0 + n4);
    const float sc = d.kind == 0 ? (d.n0 < 512 ? 0.08838834764831845f : 1.f) : 32.f;
#pragma unroll
    for (int i = 0; i < 16; ++i) { LAS float* t = scr + (4 * i + r2) * CVT_P + n4; const f32x4 v = wv[i] * sc; t[0] = v[0]; t[1] = v[1]; t[2] = v[2]; t[3] = v[3]; }
    LDS_WAIT(); asm volatile("" ::: "memory");
    const int c = lane & 7;
#pragma unroll
    for (int j = 0; j < 8; ++j) { const int n = (lane >> 3) + 8 * j, nn = d.n0 + n; const LAS float* s = scr + (8 * c) * CVT_P + n;
        if (d.kind == 0) { v4u o; o.x = pk2(s[0 * CVT_P], s[1 * CVT_P]); o.y = pk2(s[2 * CVT_P], s[3 * CVT_P]); o.z = pk2(s[4 * CVT_P], s[5 * CVT_P]); o.w = pk2(s[6 * CVT_P], s[7 * CVT_P]);
            *(v4u*)(d.WT + ((size_t)rowmap<1>(nn) * d.K + d.k0 + 8 * c) * 2) = o; }
        else { float f[8];
#pragma unroll
            for (int q = 0; q < 8; ++q) f[q] = s[q * CVT_P];
            const int row = d.kind == 2 ? rowmap<2>(nn) : nn;
            *(v2u*)(d.WT + (size_t)row * d.K + d.k0 + 8 * c) = pk8_fp8(f); } }
    LDS_WAIT(); asm volatile("" ::: "memory");
}
constexpr int I_A = I_IN + I_OUT, I_B = I_UP + I_DN;
__device__ __forceinline__ void convert_fill(Frame& F, int l, int q, int batches) {
    unsigned* head = F.ctl + CW_QCONV + (q * 4 + l) * 64;
    LAS int* slot = (LAS int*)(F.lds + MISC_OFF + 192);
    const int base = q ? I_A : 0, cnt = q ? I_B : I_A;
    const int bsz = batches < 0 ? (q ? 2 : 1) : CVT_BATCH;
    for (int n = 0; batches < 0 || n < batches; ++n) {
        __syncthreads();
        if (F.tid == 0) *slot = (int)atomicAdd(head, (unsigned)(NWAVES * bsz));
        __syncthreads();
        const int s0 = *slot;
        if (s0 >= cnt) break;
        const int start = s0 + F.wave * bsz;
        for (int k = 0; k < bsz && start + k < cnt; ++k) convert_item(F, l, base + start + k);
    }
}
__device__ __forceinline__ void p0_prologue(Frame& F) {
    p0_mod(F);
    __syncthreads();
    { unsigned* rope = WSP(unsigned, WS_ROPE);
      for (int i = F.bid * 512 + F.tid; i < 128 * 32; i += F.G * 512) { const int p = i >> 5, j = i & 31; const float fr = powf(10000.f, -(float)j / 32.f); const float ang = (float)p * fr; rope[i] = pk2(cosf(ang), sinf(ang)); } }
    { unsigned* bu = WSP(unsigned, WS_BUPH); unsigned* bd = WSP(unsigned, WS_BDNH);
      for (int i = F.bid * 512 + F.tid; i < DEPTH * NE * 1024; i += F.G * 512) bu[i] = pk2(IN_(16)[2 * i], IN_(16)[2 * i + 1]);
      for (int i = F.bid * 512 + F.tid; i < DEPTH * NE * 512; i += F.G * 512) bd[i] = pk2(IN_(18)[2 * i], IN_(18)[2 * i + 1]); }
    { unsigned* rwhl = WSP(unsigned, WS_RWHL);
      for (int idx = F.bid * 512 + F.tid; idx < DEPTH * NE * 512; idx += F.G * 512) { const int l = idx >> 14, rem = idx & 16383, e = rem & 31, kp = rem >> 5;
          const float* rw = IN_(13) + (size_t)l * D * NE; const float w0 = rw[(size_t)(2 * kp) * NE + e], w1 = rw[(size_t)(2 * kp + 1) * NE + e];
          const unsigned hi = pk2(w0, w1); rwhl[((size_t)(l * 2 + 0) * NE + e) * 512 + kp] = hi; rwhl[((size_t)(l * 2 + 1) * NE + e) * 512 + kp] = pk2(w0 - bflo(hi), w1 - bfhi(hi)); } }
    convert_fill(F, 0, 0, -1);
}
__device__ __forceinline__ void moe_offsets(Frame& F, int l) {
    LAS int* toff = (LAS int*)(F.lds + MISC_OFF + 256);
    if (F.tid < 64) {
        const int e = F.tid & 31; const int cnt = (int)__hip_atomic_load(&F.ctl[CW_GCNT + (l * 32 + e) * 64], __ATOMIC_RELAXED, __HIP_MEMORY_SCOPE_AGENT);
        const int tiles = (cnt + 255) >> 8; int incl = tiles;
#pragma unroll
        for (int o = 1; o < 32; o <<= 1) { const int t = shl_i(incl, (F.tid - o) & 63); if (e >= o) incl += t; }
        if (F.tid < 32) { toff[e] = incl - tiles; toff[33 + e] = cnt; if (e == 31) toff[32] = incl; }
    }
    __syncthreads();
    { LAS unsigned char* texp = (LAS unsigned char*)(F.lds + MISC_OFF + 1024);
      const int NT = toff[32];
      for (int rt = F.tid; rt < NT && rt < 1024; rt += 512) { int e = 0;
#pragma unroll
          for (int k = 1; k < NE; ++k) e += (toff[k] <= rt) ? 1 : 0;
          texp[rt] = (unsigned char)e; } }
    __syncthreads();
}

template <bool FINAL> __device__ __forceinline__ void row_phase(Frame& F, int l) {
    const int gw = F.bid * NWAVES + F.wave, NGW = F.G * NWAVES, lane = F.lane;
    constexpr int NR = FINAL ? TL : TT;
    const bf16* XA = WSP(bf16, WS_X); bf16* XB = WSP(bf16, WS_XB); bf16* HB = WSP(bf16, WS_HB); const unsigned char* YB = WSP(unsigned char, WS_YB);
    const int* ae = WSP(int, WS_ASG); const int* ark = WSP(int, WS_ASG + 1 * MiB); const float* aw = WSP(float, WS_ASG + 3 * MiB); const float* MODV = WSP(float, WS_MODV);
    const LAS int* toff = (const LAS int*)(F.lds + MISC_OFF + 256);
    if (!FINAL && l > 0) { convert_fill(F, l, 0, -1); __syncthreads(); }
    if (MK_MULTI && l > 0) moe_offsets(F, l - 1);
    auto finish = [&](f32x4 (&v)[2][4], int r0, int s) {
#pragma unroll
        for (int q = 0; q < 2; ++q) {
            const int r = r0 + q;
            if (!FINAL) {
#pragma unroll
                for (int j = 0; j < 4; ++j) { v2u o; o.x = pk2(v[q][j].x, v[q][j].y); o.y = pk2(v[q][j].z, v[q][j].w); ((v2u*)(XB + (size_t)r * D))[lane + 64 * j] = o; }
            }
            float ss = 0.f;
#pragma unroll
            for (int j = 0; j < 4; ++j) ss += (v[q][j].x * v[q][j].x + v[q][j].y * v[q][j].y) + (v[q][j].z * v[q][j].z + v[q][j].w * v[q][j].w);
            const float rms = 1.f / sqrtf(wave_sum(ss, lane) * (1.f / D) + EPS);
            if (FINAL) {
#pragma unroll
                for (int j = 0; j < 4; ++j) ((f32x4*)(F.out + (size_t)r * D))[lane + 64 * j] = v[q][j] * rms * ((const f32x4*)IN_(19))[lane + 64 * j];
            } else {
                const float* nm = IN_(6) + (size_t)l * D; const float* sh = MODV + (size_t)(l * 5 + s) * 6144; const float* sc = sh + 1024;
#pragma unroll
                for (int j = 0; j < 4; ++j) { const f32x4 h = v[q][j] * rms * ((const f32x4*)nm)[lane + 64 * j] * (((const f32x4*)sc)[lane + 64 * j] + 1.f) + ((const f32x4*)sh)[lane + 64 * j];
                    v2u o; o.x = pk2(h.x, h.y); o.y = pk2(h.z, h.w); ((v2u*)(HB + (size_t)r * D))[lane + 64 * j] = o; }
            }
        }
    };
    const int step = 2 * NGW;
    if (l == 0) {
        for (int r0 = 2 * gw; r0 < NR; r0 += step) {
            const int s = r0 < TL ? (r0 >> 13) : 4;
            f32x4 v[2][4];
            const f32x4* src = (const f32x4*)(r0 < TL ? IN_(0) + (size_t)r0 * D : IN_(2) + (size_t)(r0 - TL) * D);
#pragma unroll
            for (int q = 0; q < 2; ++q)
#pragma unroll
                for (int j = 0; j < 4; ++j) v[q][j] = src[q * 256 + lane + 64 * j];
            finish(v, r0, s);
        }
        return;
    }
    int r0 = 2 * gw;
    if (r0 >= NR) return;
    auto ldasg = [&](int rr, int& e, int& rk, float& w) { const size_t o = (size_t)rr * 4 + (lane & 7); e = ae[o]; rk = ark[o]; w = aw[o]; };
    auto ldrows = [&](int rr, int e, int rk, v2u (&x)[2][4], int (&y)[2][4][4]) {
        const v2u* src = (const v2u*)(XA + (size_t)rr * D);
#pragma unroll
        for (int q = 0; q < 2; ++q)
#pragma unroll
            for (int j = 0; j < 4; ++j) x[q][j] = src[q * 256 + lane + 64 * j];
        const int pv = 256 * toff[e] + rk;
#pragma unroll
        for (int q = 0; q < 2; ++q)
#pragma unroll
            for (int k = 0; k < 4; ++k) { const int p = shl_i(pv, q * 4 + k); const int* yrow = (const int*)(YB + (size_t)p * 1024);
#pragma unroll
                for (int j = 0; j < 4; ++j) y[q][k][j] = yrow[lane + 64 * j]; }
    };
    int e1 = 0, k1 = 0; float w1 = 0.f, wcur;
    v2u xc[2][4]; int yc[2][4][4];
    { int e0, k0; ldasg(r0, e0, k0, wcur); if (r0 + step < NR) ldasg(r0 + step, e1, k1, w1); ldrows(r0, e0, k0, xc, yc); }
#pragma unroll 1
    for (; r0 < NR; r0 += step) {
        const int rn = r0 + step; const bool hn = rn < NR;
        v2u xn[2][4]; int yn[2][4][4]; const float wn = w1;
        int e2 = 0, k2 = 0; float w2 = 0.f;
        if (hn) { ldrows(rn, e1, k1, xn, yn); if (rn + step < NR) ldasg(rn + step, e2, k2, w2); }
        asm volatile("" ::: "memory");
        const int s = r0 < TL ? (r0 >> 13) : 4;
        const float* g2 = MODV + (size_t)((l - 1) * 5 + s) * 6144 + 5 * 1024;
        f32x4 v[2][4];
#pragma unroll
        for (int q = 0; q < 2; ++q)
#pragma unroll
            for (int j = 0; j < 4; ++j) { const v2u x = xc[q][j]; f32x4 a = (f32x4){0.f, 0.f, 0.f, 0.f};
#pragma unroll
                for (int k = 0; k < 4; ++k) { const float wk = shl_f(wcur, q * 4 + k); const f32x2_t lo = __builtin_amdgcn_cvt_pk_f32_fp8(yc[q][k][j], false), hi = __builtin_amdgcn_cvt_pk_f32_fp8(yc[q][k][j], true); a += wk * (f32x4){lo[0], lo[1], hi[0], hi[1]}; }
                v[q][j] = (f32x4){bflo(x.x), bfhi(x.x), bflo(x.y), bfhi(x.y)} + ((const f32x4*)g2)[lane + 64 * j] * a; }
        finish(v, r0, s);
        if (hn) {
#pragma unroll
            for (int q = 0; q < 2; ++q)
#pragma unroll
                for (int j = 0; j < 4; ++j) { xc[q][j] = xn[q][j];
#pragma unroll
                    for (int k = 0; k < 4; ++k) yc[q][k][j] = yn[q][k][j]; }
        }
        wcur = wn; e1 = e2; k1 = k2; w1 = w2;
    }
}

struct EpiWin {
    static constexpr bool PERM = true, PERM16 = false, AFTER_DRAIN = false; static constexpr int NVM = MK_MULTI ? 0 : 8;
    unsigned char* ws; int probe;
    __device__ __forceinline__ void prefetch(LAS unsigned char*, const pg8::Unit&, int, int, int, int) const {}
    __device__ __forceinline__ void operator()(const f32x4 (&acc)[2][2][4][2], const pg8::Unit& u, int wr, int wc, int fr, int fq, const LAS unsigned char*) const {
        if (MK_MULTI && (probe == 2 || probe == 4)) { _Pragma("unroll") for (int a = 0; a < 2; ++a) _Pragma("unroll") for (int b2 = 0; b2 < 2; ++b2) _Pragma("unroll") for (int m = 0; m < 4; ++m) _Pragma("unroll") for (int n = 0; n < 2; ++n) asm volatile("" :: "v"(acc[a][b2][m][n])); return; }
        const int pn = u.pn; size_t boff; int ld, cofs;
        if (pn < 2) { boff = WS_QB; ld = 512; cofs = pn * 256; } else if (pn < 4) { boff = WS_KB; ld = 512; cofs = (pn - 2) * 256; }
        else if (pn < 8) { boff = WS_VB; ld = 1024; cofs = (pn - 4) * 256; } else if (pn < 12) { boff = WS_GB; ld = 1024; cofs = (pn - 8) * 256; }
        else if (pn < 14) { boff = WS_CBB; ld = 512; cofs = (pn - 12) * 256; } else { boff = WS_CCB; ld = 512; cofs = (pn - 14) * 128; }
        bf16* base = (bf16*)(ws + boff);
        const int row0 = u.pm * 256 + wr * 64 + fr, col0 = cofs + wc * 32 + 8 * fq;
        const bool rope_on = (pn < 4) && (u.pm < TL / 256);
        if (pn >= 14) {
#pragma unroll
            for (int ai = 0; ai < 2; ++ai)
#pragma unroll
                for (int m = 0; m < 4; ++m) { bf16* rowp = base + (size_t)(row0 + ai * 128 + m * 16) * ld + col0;
                    const f32x4 a = acc[ai][0][m][0] * acc[ai][1][m][0], b = acc[ai][0][m][1] * acc[ai][1][m][1];
                    v4u w; w.x = pk2(a[0], a[1]); w.y = pk2(a[2], a[3]); w.z = pk2(b[0], b[1]); w.w = pk2(b[2], b[3]);
                    if (MK_MULTI && probe == 1) asm volatile("" :: "v"(w)); else *(v4u*)rowp = w; }
            return;
        }
        if (!rope_on) {
#pragma unroll
            for (int ai = 0; ai < 2; ++ai)
#pragma unroll
                for (int m = 0; m < 4; ++m) { bf16* rowp = base + (size_t)(row0 + ai * 128 + m * 16) * ld + col0;
#pragma unroll
                    for (int bj = 0; bj < 2; ++bj) { const f32x4 a = acc[ai][bj][m][0], b = acc[ai][bj][m][1];
                        v4u w; w.x = pk2(a[0], a[1]); w.y = pk2(a[2], a[3]); w.z = pk2(b[0], b[1]); w.w = pk2(b[2], b[3]);
                        if (MK_MULTI && probe == 1) asm volatile("" :: "v"(w)); else *(v4u*)(rowp + bj * 128) = w; } }
            return;
        }
        float frev[4];
#pragma unroll
        for (int k = 0; k < 4; ++k) frev[k] = __builtin_amdgcn_exp2f(-(float)(16 * (wc & 1) + 4 * fq + k) * 0.41524101186092033f) * 0.15915494309189535f;
#pragma unroll
        for (int ai = 0; ai < 2; ++ai)
#pragma unroll
            for (int m = 0; m < 4; ++m) {
                const int r = row0 + ai * 128 + m * 16; bf16* rowp = base + (size_t)r * ld + col0;
                f32x4 c01 = (f32x4){1.f, 0.f, 1.f, 0.f}, c23 = c01;
                if (rope_on) { const int t = r & (SEQ - 1); const float pos = (float)((wc >> 1) ? (t & 63) : (t >> 6));
                    c01 = (f32x4){__builtin_amdgcn_cosf(pos * frev[0]), __builtin_amdgcn_sinf(pos * frev[0]), __builtin_amdgcn_cosf(pos * frev[1]), __builtin_amdgcn_sinf(pos * frev[1])};
                    c23 = (f32x4){__builtin_amdgcn_cosf(pos * frev[2]), __builtin_amdgcn_sinf(pos * frev[2]), __builtin_amdgcn_cosf(pos * frev[3]), __builtin_amdgcn_sinf(pos * frev[3])}; }
#pragma unroll
                for (int bj = 0; bj < 2; ++bj) { const f32x4 a = acc[ai][bj][m][0], b = acc[ai][bj][m][1];
                    f32x4 o0, o1;
                    o0[0] = a[0] * c01[0] - a[1] * c01[1]; o0[1] = a[0] * c01[1] + a[1] * c01[0]; o0[2] = a[2] * c01[2] - a[3] * c01[3]; o0[3] = a[2] * c01[3] + a[3] * c01[2];
                    o1[0] = b[0] * c23[0] - b[1] * c23[1]; o1[1] = b[0] * c23[1] + b[1] * c23[0]; o1[2] = b[2] * c23[2] - b[3] * c23[3]; o1[3] = b[2] * c23[3] + b[3] * c23[2];
                    v4u w; w.x = pk2(o0[0], o0[1]); w.y = pk2(o0[2], o0[3]); w.z = pk2(o1[0], o1[1]); w.w = pk2(o1[2], o1[3]);
                    if (MK_MULTI && probe == 1) asm volatile("" :: "v"(w)); else *(v4u*)(rowp + bj * 128) = w; }
            }
    }
};
struct EpiWout {
    static constexpr bool PERM = true, PERM16 = false, AFTER_DRAIN = false; static constexpr int NVM = 32;
    bf16* X; const bf16* XBp; const bf16* g1h;
    __device__ __forceinline__ void prefetch(LAS unsigned char* pre, const pg8::Unit& u, int wr, int wc, int fr, int fq) const {
        const int s = u.pm < TL / 256 ? (u.pm >> 5) : 4; const bf16* g1 = g1h + (size_t)s * 1024 + u.pn * 256 + wc * 32 + 8 * fq;
        __builtin_amdgcn_global_load_lds((const unsigned*)g1, (LAS unsigned*)pre, 16, 0, 0); __builtin_amdgcn_global_load_lds((const unsigned*)(g1 + 128), (LAS unsigned*)(pre + 1024), 16, 0, 0);
    }
    __device__ __forceinline__ void operator()(const f32x4 (&acc)[2][2][4][2], const pg8::Unit& u, int wr, int wc, int fr, int fq, const LAS unsigned char* pre) const {
        f32x4 gv[2][2];
#pragma unroll
        for (int bj = 0; bj < 2; ++bj) { const v4u x = *(const LAS v4u*)(pre + bj * 1024 + (fq * 16 + fr) * 16); gv[bj][0] = (f32x4){bflo(x.x), bfhi(x.x), bflo(x.y), bfhi(x.y)}; gv[bj][1] = (f32x4){bflo(x.z), bfhi(x.z), bflo(x.w), bfhi(x.w)}; }
        const int row0 = u.pm * 256 + wr * 64 + fr, col0 = u.pn * 256 + wc * 32 + 8 * fq;
#pragma unroll
        for (int ai = 0; ai < 2; ++ai) {
            v4u xb[4][2];
#pragma unroll
            for (int m = 0; m < 4; ++m)
#pragma unroll
                for (int bj = 0; bj < 2; ++bj) xb[m][bj] = *(const v4u*)(XBp + (size_t)(row0 + ai * 128 + m * 16) * D + col0 + bj * 128);
#pragma unroll
            for (int m = 0; m < 4; ++m) { const size_t ro = (size_t)(row0 + ai * 128 + m * 16) * D + col0;
#pragma unroll
                for (int bj = 0; bj < 2; ++bj) { const v4u x = xb[m][bj];
                    const f32x4 v0 = (f32x4){bflo(x.x), bfhi(x.x), bflo(x.y), bfhi(x.y)} + gv[bj][0] * acc[ai][bj][m][0], v1 = (f32x4){bflo(x.z), bfhi(x.z), bflo(x.w), bfhi(x.w)} + gv[bj][1] * acc[ai][bj][m][1];
                    v4u w; w.x = pk2(v0[0], v0[1]); w.y = pk2(v0[2], v0[3]); w.z = pk2(v1[0], v1[1]); w.w = pk2(v1[2], v1[3]);
                    *(v4u*)(X + ro + bj * 128) = w; } }
            asm volatile("" ::: "memory");
        }
    }
};
struct EpiUp {
    static constexpr bool PERM = true, PERM16 = false, AFTER_DRAIN = false; static constexpr int NVM = MK_MULTI ? 0 : 4;
    unsigned char* ACT; const bf16* bup; int probe;
    __device__ __forceinline__ void prefetch(LAS unsigned char* pre, const pg8::Unit& u, int wr, int wc, int fr, int fq) const {
        const bf16* bgp = bup + (size_t)(u.pn >> 3) * 2048 + (u.pn & 7) * 128 + wc * 32 + 8 * fq;
        __builtin_amdgcn_global_load_lds((const unsigned*)bgp, (LAS unsigned*)pre, 16, 0, 0); __builtin_amdgcn_global_load_lds((const unsigned*)(bgp + 1024), (LAS unsigned*)(pre + 1024), 16, 0, 0);
    }
    __device__ __forceinline__ void operator()(const f32x4 (&acc)[2][2][4][2], const pg8::Unit& u, int wr, int wc, int fr, int fq, const LAS unsigned char* pre) const {
        if (MK_MULTI && (probe == 2 || probe == 4)) { _Pragma("unroll") for (int a = 0; a < 2; ++a) _Pragma("unroll") for (int b2 = 0; b2 < 2; ++b2) _Pragma("unroll") for (int m = 0; m < 4; ++m) _Pragma("unroll") for (int n = 0; n < 2; ++n) asm volatile("" :: "v"(acc[a][b2][m][n])); return; }
        struct { v4u bg, bl; } P; P.bg = *(const LAS v4u*)(pre + (fq * 16 + fr) * 16); P.bl = *(const LAS v4u*)(pre + 1024 + (fq * 16 + fr) * 16);
        const int pnl = u.pn & 7, row0 = u.pm * 256 + wr * 64 + fr, col0 = pnl * 128 + wc * 32 + 8 * fq;
        const f32x4 bgv[2] = {(f32x4){bflo(P.bg.x), bfhi(P.bg.x), bflo(P.bg.y), bfhi(P.bg.y)}, (f32x4){bflo(P.bg.z), bfhi(P.bg.z), bflo(P.bg.w), bfhi(P.bg.w)}};
        const f32x4 blv[2] = {(f32x4){bflo(P.bl.x), bfhi(P.bl.x), bflo(P.bl.y), bfhi(P.bl.y)} + 1.0f, (f32x4){bflo(P.bl.z), bfhi(P.bl.z), bflo(P.bl.w), bfhi(P.bl.w)} + 1.0f};
        unsigned char* const rowb = ACT + (size_t)(row0 + (fq & 1) * 16) * 1024 + col0 - 8 * (fq & 1);
#pragma unroll
        for (int ai = 0; ai < 2; ++ai)
#pragma unroll
            for (int mp = 0; mp < 2; ++mp) {
                v2u pc[2];
#pragma unroll
                for (int mm = 0; mm < 2; ++mm) { const int m = 2 * mp + mm;
                    f32x4 o[2];
#pragma unroll
                    for (int n = 0; n < 2; ++n) { const f32x4 g = acc[ai][0][m][n] * 0.03125f + bgv[n], li = acc[ai][1][m][n] * 0.03125f + blv[n];
#pragma unroll
                        for (int q2 = 0; q2 < 2; ++q2) {
                            f32x2_t gg = {__builtin_amdgcn_fmed3f(g[2 * q2], -16.f, 7.f), __builtin_amdgcn_fmed3f(g[2 * q2 + 1], -16.f, 7.f)}; const f32x2_t ll = {__builtin_amdgcn_fmed3f(li[2 * q2], -6.f, 8.f), __builtin_amdgcn_fmed3f(li[2 * q2 + 1], -6.f, 8.f)};
                            const f32x2_t t = gg * (-1.702f * 1.44269504088896f); f32x2_t e2; e2[0] = __builtin_amdgcn_exp2f(t[0]); e2[1] = __builtin_amdgcn_exp2f(t[1]);
                            const f32x2_t d = e2 + 1.0f; const float rp = __builtin_amdgcn_rcpf(d[0] * d[1]); const f32x2_t rr = {d[1] * rp, d[0] * rp};
                            const f32x2_t r2 = (gg * rr) * ll; o[n][2 * q2] = r2[0]; o[n][2 * q2 + 1] = r2[1]; } }
                    const float f8[8] = {o[0][0], o[0][1], o[0][2], o[0][3], o[1][0], o[1][1], o[1][2], o[1][3]}; pc[mm] = pk8_fp8(f8); }
                const auto sx = __builtin_amdgcn_permlane16_swap(pc[0].x, pc[1].x, false, false), sy = __builtin_amdgcn_permlane16_swap(pc[0].y, pc[1].y, false, false);
                if (MK_MULTI && probe == 1) asm volatile("" :: "v"(sx), "v"(sy)); else *(v4u*)(rowb + (size_t)(ai * 128 + mp * 32) * 1024) = (v4u){sx[0], sy[0], sx[1], sy[1]};
                asm volatile("" ::: "memory"); }
    }
};
struct EpiDown {
    static constexpr int NVM = MK_MULTI ? 0 : 8;
    static constexpr bool PERM = true, PERM16 = true, AFTER_DRAIN = false;
    unsigned char* YB; const bf16* bdn; int probe;
    __device__ __forceinline__ void prefetch(LAS unsigned char* pre, const pg8::Unit& u, int wr, int wc, int fr, int fq) const {
        const bf16* bp = bdn + (size_t)(u.pn >> 2) * 1024 + (u.pn & 3) * 256 + wc * 64 + 16 * fq;
        __builtin_amdgcn_global_load_lds((const unsigned*)bp, (LAS unsigned*)pre, 16, 0, 0); __builtin_amdgcn_global_load_lds((const unsigned*)(bp + 8), (LAS unsigned*)(pre + 1024), 16, 0, 0);
    }
    __device__ __forceinline__ void operator()(const f32x4 (&acc)[2][2][4][2], const pg8::Unit& u, int wr, int wc, int fr, int fq, const LAS unsigned char* pre) const {
        struct { v4u bb[2]; } P; P.bb[0] = *(const LAS v4u*)(pre + (fq * 16 + fr) * 16); P.bb[1] = *(const LAS v4u*)(pre + 1024 + (fq * 16 + fr) * 16);
        if (MK_MULTI && (probe == 2 || probe == 4)) { _Pragma("unroll") for (int a = 0; a < 2; ++a) _Pragma("unroll") for (int b2 = 0; b2 < 2; ++b2) _Pragma("unroll") for (int m = 0; m < 4; ++m) _Pragma("unroll") for (int n = 0; n < 2; ++n) asm volatile("" :: "v"(acc[a][b2][m][n])); return; }
        const int pnl = u.pn & 3, row0 = u.pm * 256 + wr * 64 + fr, col0 = pnl * 256 + wc * 64 + 16 * fq;
        f32x4 bv[2][2];
#pragma unroll
        for (int bj = 0; bj < 2; ++bj) { const v4u x = P.bb[bj]; bv[bj][0] = (f32x4){bflo(x.x), bfhi(x.x), bflo(x.y), bfhi(x.y)}; bv[bj][1] = (f32x4){bflo(x.z), bfhi(x.z), bflo(x.w), bfhi(x.w)}; }
#pragma unroll
        for (int ai = 0; ai < 2; ++ai)
#pragma unroll
            for (int m = 0; m < 4; ++m) { unsigned char* rowp = YB + (size_t)(row0 + ai * 128 + m * 16) * 1024 + col0;
                v4u w;
#pragma unroll
                for (int bj = 0; bj < 2; ++bj) { const f32x4 v0 = acc[ai][bj][m][0] * 0.03125f + bv[bj][0], v1 = acc[ai][bj][m][1] * 0.03125f + bv[bj][1];
                    const float f8[8] = {v0[0], v0[1], v0[2], v0[3], v1[0], v1[1], v1[2], v1[3]}; const v2u h = pk8_fp8(f8);
                    if (bj == 0) { w.x = h.x; w.y = h.y; } else { w.z = h.x; w.w = h.y; } }
                if (MK_MULTI && probe == 1) asm volatile("" :: "v"(w)); else *(v4u*)rowp = w; }
    }
};
struct MoeOrder {
    const LAS int* toff; int NT, ncol, shift, G, c; const int* tlist;
    __device__ __forceinline__ int arow(const pg8::Unit& u, int row) const {
        const int e = u.pn >> shift, cnt = toff[33 + e]; int idx = (u.pm - toff[e]) * 256 + row; idx = idx < cnt ? idx : cnt - 1; return tlist[(size_t)e * TT + idx]; }
    __device__ __forceinline__ bool next(int i, pg8::Unit& u) const {
        const int x = c & 7, qq = c >> 3, rpx = 32 >> shift;
        const int rt = (G == 256) ? (i * 8 + x) * rpx + (qq >> shift) : (int)(((long)i * G + c) >> shift);
        const int pnl = (G == 256) ? (qq & (ncol - 1)) : (int)(((long)i * G + c) & (ncol - 1));
        if (rt >= NT) return false;
        const int e = ((const LAS unsigned char*)toff)[1024 - 256 + rt];
        u.pm = rt; u.pn = __builtin_amdgcn_readfirstlane(e * ncol + pnl); return true;
    }
    __device__ __forceinline__ void a_ready(const pg8::Unit&) const {}
    __device__ __forceinline__ void done(const pg8::Unit&) const {}
};

__device__ __forceinline__ bf16x8 trpair(const LAS unsigned char* p, int off2) {
    typedef short v4i16_t __attribute__((ext_vector_type(4)));
    const v4i16_t lo = __builtin_amdgcn_ds_read_tr16_b64_v4i16((LAS v4i16_t*)p);
    const v4i16_t hi = __builtin_amdgcn_ds_read_tr16_b64_v4i16((LAS v4i16_t*)(p + off2));
    return (bf16x8){lo[0], lo[1], lo[2], lo[3], hi[0], hi[1], hi[2], hi[3]};
}
__device__ __forceinline__ v4u scale8(v4u x, float s) { v4u o; o.x = pk2(bflo(x.x) * s, bfhi(x.x) * s); o.y = pk2(bflo(x.y) * s, bfhi(x.y) * s); o.z = pk2(bflo(x.z) * s, bfhi(x.z) * s); o.w = pk2(bflo(x.w) * s, bfhi(x.w) * s); return o; }
__device__ __forceinline__ int chunk_row0(int b, int cidx) { return cidx < 2 ? TL + b * LC + cidx * 128 : b * SEQ + (cidx - 2) * 128; }
__device__ __forceinline__ void stage128(LAS unsigned char* dst, const bf16* src, int ld, int tid) {
#pragma unroll
    for (int it = 0; it < 4; ++it) { const int pc = tid + 512 * it, s = pc >> 4, ch = pc & 15; *(LAS v4u*)(dst + s * RPITCH + ch * 16) = *(const v4u*)(src + (size_t)s * ld + ch * 8); }
}
__device__ __forceinline__ void r1_load(v4u (&rk)[4], v4u (&rv)[4], const bf16* KB, const bf16* VB, int u, int tid) {
    const int eh = u & 1, cu = u >> 1, bh = cu / NCH, cidx = cu % NCH, b = bh >> 2, h = bh & 3, row0 = chunk_row0(b, cidx);
#pragma unroll
    for (int it = 0; it < 4; ++it) { const int pc = tid + 512 * it, s = pc >> 4, ch = pc & 15;
        rk[it] = *(const v4u*)(KB + (size_t)(row0 + s) * QKW + h * DK + ch * 8); rv[it] = *(const v4u*)(VB + (size_t)(row0 + s) * RWD + h * DV + eh * 128 + ch * 8); }
}
__device__ __forceinline__ void r1_phase(Frame& F, int l) {
    LAS unsigned char* Kf = F.lds; LAS unsigned char* Kb = F.lds + 128 * RPITCH; LAS unsigned char* Vh = F.lds + 2 * 128 * RPITCH;
    const bf16* KB = WSP(bf16, WS_KB); const bf16* VB = WSP(bf16, WS_VB); unsigned char* KVF = WSP(unsigned char, WS_KVF); unsigned char* KVB = WSP(unsigned char, WS_KVB);
    const int w = F.wave; constexpr int NU = 16 * NCH * 2;
    int u = F.bid;
    if (u >= NU) return;
    v4u rk[4], rv[4];
    r1_load(rk, rv, KB, VB, u, F.tid);
    for (; u < NU; u += F.G) {
        int tid = F.tid; asm volatile("" : "+v"(tid));
        const int lane = tid & 63, g = lane >> 4, i = lane & 15, q = i >> 2, p = i & 3;
        const int eh = u & 1, cu = u >> 1, bh = cu / NCH, cidx = cu % NCH, h = bh & 3;
        const float lgf = logsig(IN_(9)[l * NH + h]), lgb = logsig(IN_(10)[l * NH + h]);
#pragma unroll
        for (int it = 0; it < 4; ++it) { const int pc = tid + 512 * it, s = pc >> 4, ch = pc & 15;
            const float wf = fexp((float)(127 - s) * lgf), wb = fexp((float)s * lgb);
            *(LAS v4u*)(Kf + s * RPITCH + ch * 16) = scale8(rk[it], wf); *(LAS v4u*)(Kb + s * RPITCH + ch * 16) = scale8(rk[it], wb);
            *(LAS v4u*)(Vh + s * RPITCH + ch * 16) = rv[it]; }
        __syncthreads();
        if (u + F.G < NU) r1_load(rk, rv, KB, VB, u + F.G, tid);
        asm volatile("" ::: "memory");
        f32x4 af[8], ab[8];
#pragma unroll
        for (int dt = 0; dt < 8; ++dt) { af[dt] = (f32x4){0.f, 0.f, 0.f, 0.f}; ab[dt] = af[dt]; }
#pragma unroll
        for (int uu = 0; uu < 4; ++uu) {
            const int roff = (32 * uu + 8 * g + q) * RPITCH;
            const bf16x8 vf = trpair(Vh + roff + (16 * w + 4 * p) * 2, 4 * RPITCH);
#pragma unroll
            for (int dt = 0; dt < 8; ++dt) {
                const int dcol = 32 * (dt >> 1) + 8 * p + 4 * (dt & 1);
                const bf16x8 kf = trpair(Kf + roff + dcol * 2, 4 * RPITCH);
                const bf16x8 kb = trpair(Kb + roff + dcol * 2, 4 * RPITCH);
                af[dt] = __builtin_amdgcn_mfma_f32_16x16x32_bf16(kf, vf, af[dt], 0, 0, 0);
                ab[dt] = __builtin_amdgcn_mfma_f32_16x16x32_bf16(kb, vf, ab[dt], 0, 0, 0);
            }
        }
        const size_t o = ((size_t)(bh * NCH + cidx) * DV + 128 * eh + 16 * w + i) * DK + 8 * g;
#pragma unroll
        for (int k = 0; k < 4; ++k) { float ff[8], fb[8];
#pragma unroll
            for (int x = 0; x < 8; ++x) { ff[x] = __builtin_amdgcn_fmed3f(af[2 * k + (x >> 2)][x & 3], -448.f, 448.f); fb[x] = __builtin_amdgcn_fmed3f(ab[2 * k + (x >> 2)][x & 3], -448.f, 448.f); }
            *(v2u*)(KVF + o + 32 * k) = pk8_fp8(ff); *(v2u*)(KVB + o + 32 * k) = pk8_fp8(fb); }
        __syncthreads();
    }
}
__device__ __forceinline__ void conv_phase(Frame& F, int l) {
    const bf16* CB = WSP(bf16, WS_CBB); const bf16* CU = WSP(bf16, WS_CCB); unsigned char* MIX = WSP(unsigned char, WS_MIX);
    const float* cw = IN_(11) + (size_t)l * 3 * CWD;
    for (int idx = F.bid * 512 + F.tid; idx < TT * 64; idx += F.G * 512) {
        const int r = idx >> 6, ch0 = (idx & 63) * 8;
        const bool hp = r < TL ? ((r & 63) != 0) : ((r & 255) != 0), hn = r < TL ? ((r & 63) != 63) : ((r & 255) != 255);
        const size_t o = (size_t)r * CWD + ch0;
        const v4u u1 = *(const v4u*)(CU + o), bb = *(const v4u*)(CB + o);
        v4u u0 = (v4u){0u, 0u, 0u, 0u}, u2 = u0;
        if (hp) u0 = *(const v4u*)(CU + o - CWD);
        if (hn) u2 = *(const v4u*)(CU + o + CWD);
        const f32x4 w0a = *(const f32x4*)(cw + ch0), w0b = *(const f32x4*)(cw + ch0 + 4), w1a = *(const f32x4*)(cw + CWD + ch0), w1b = *(const f32x4*)(cw + CWD + ch0 + 4), w2a = *(const f32x4*)(cw + 2 * CWD + ch0), w2b = *(const f32x4*)(cw + 2 * CWD + ch0 + 4);
        float res[8];
#pragma unroll
        for (int k = 0; k < 4; ++k) {
            const unsigned a0 = u0[k], a1 = u1[k], a2 = u2[k], cbw = bb[k];
            const float wl0 = k < 2 ? w0a[2 * k] : w0b[2 * k - 4], wh0 = k < 2 ? w0a[2 * k + 1] : w0b[2 * k - 3];
            const float wl1 = k < 2 ? w1a[2 * k] : w1b[2 * k - 4], wh1 = k < 2 ? w1a[2 * k + 1] : w1b[2 * k - 3];
            const float wl2 = k < 2 ? w2a[2 * k] : w2b[2 * k - 4], wh2 = k < 2 ? w2a[2 * k + 1] : w2b[2 * k - 3];
            res[2 * k] = bflo(cbw) * (bflo(a0) * wl0 + bflo(a1) * wl1 + bflo(a2) * wl2);
            res[2 * k + 1] = bfhi(cbw) * (bfhi(a0) * wh0 + bfhi(a1) * wh1 + bfhi(a2) * wh2);
        }
#pragma unroll
        for (int k = 0; k < 8; ++k) res[k] = __builtin_amdgcn_fmed3f(res[k], -448.f, 448.f);
        *(v2u*)(MIX + (size_t)r * MIXW + RWD + ch0) = pk8_fp8(res);
    }
}
__device__ __forceinline__ int scan_order(int dir, int o) { return dir == 0 ? o : (o == 0 ? 1 : (o == 1 ? 0 : 67 - o)); }
__device__ __forceinline__ void scan_phase(Frame& F, int l) {
    for (int gid = F.bid * 512 + F.tid; gid < 2 * 16 * 4096; gid += F.G * 512) {
        const int dir = gid >> 16, rem = gid & 65535, bh = rem >> 12, vec = rem & 4095, h = bh & 3;
        const size_t boff = (size_t)bh * NCH * 32768 + vec * 8;
        const unsigned char* base = (dir ? WSP(unsigned char, WS_KVB) : WSP(unsigned char, WS_KVF)) + boff; unsigned char* obase = (dir ? WSP(unsigned char, WS_SB) : WSP(unsigned char, WS_SF)) + boff;
        const float dc = expf(128.f * logsig((dir ? IN_(10) : IN_(9))[l * NH + h]));
        float s[8];
#pragma unroll
        for (int k = 0; k < 8; ++k) s[k] = 0.f;
#pragma unroll 1
        for (int bt = 0; bt < 6; ++bt) {
            v2u kv[11];
#pragma unroll
            for (int j = 0; j < 11; ++j) kv[j] = *(const v2u*)(base + (size_t)scan_order(dir, bt * 11 + j) * 32768);
#pragma unroll
            for (int j = 0; j < 11; ++j) {
                { float f8[8];
#pragma unroll
                  for (int k = 0; k < 8; ++k) f8[k] = __builtin_amdgcn_fmed3f(s[k] * 0.25f, -448.f, 448.f);
                  *(v2u*)(obase + (size_t)scan_order(dir, bt * 11 + j) * 32768) = pk8_fp8(f8); }
#pragma unroll
                for (int k2 = 0; k2 < 2; ++k2) { const int wd = (int)kv[j][k2]; const f32x2_t lo = __builtin_amdgcn_cvt_pk_f32_fp8(wd, false), hi = __builtin_amdgcn_cvt_pk_f32_fp8(wd, true);
                    s[4 * k2] = s[4 * k2] * dc + lo[0]; s[4 * k2 + 1] = s[4 * k2 + 1] * dc + lo[1]; s[4 * k2 + 2] = s[4 * k2 + 2] * dc + hi[0]; s[4 * k2 + 3] = s[4 * k2 + 3] * dc + hi[1]; }
            }
        }
    }
}
__device__ __forceinline__ void ld128(v4u (&dst)[4], const bf16* src, int ld, int tid) {
#pragma unroll
    for (int it = 0; it < 4; ++it) { const int pc = tid + 512 * it, s = pc >> 4, ch = pc & 15; dst[it] = *(const v4u*)(src + (size_t)s * ld + ch * 8); }
}
__device__ __forceinline__ void ld128f8(v2u (&dst)[4], const unsigned char* src, int tid) {
#pragma unroll
    for (int it = 0; it < 4; ++it) { const int pc = tid + 512 * it; dst[it] = *(const v2u*)(src + (size_t)pc * 8); }
}
__device__ __forceinline__ void st128f8(LAS unsigned char* dst, const v2u (&r)[4], int tid) {
#pragma unroll
    for (int it = 0; it < 4; ++it) { const int pc = tid + 512 * it, s = pc >> 4, ch = pc & 15;
        const f32x2_t a = __builtin_amdgcn_cvt_pk_f32_fp8((int)r[it].x, false), b = __builtin_amdgcn_cvt_pk_f32_fp8((int)r[it].x, true), c = __builtin_amdgcn_cvt_pk_f32_fp8((int)r[it].y, false), d = __builtin_amdgcn_cvt_pk_f32_fp8((int)r[it].y, true);
        v4u o; o.x = pk2(a[0], a[1]); o.y = pk2(b[0], b[1]); o.z = pk2(c[0], c[1]); o.w = pk2(d[0], d[1]);
        *(LAS v4u*)(dst + s * RPITCH + ch * 16) = o; }
}
__device__ __forceinline__ void st128(LAS unsigned char* dst, const v4u (&r)[4], int tid) {
#pragma unroll
    for (int it = 0; it < 4; ++it) { const int pc = tid + 512 * it, s = pc >> 4, ch = pc & 15; *(LAS v4u*)(dst + s * RPITCH + ch * 16) = r[it]; }
}
__device__ __forceinline__ void r3_phase(Frame& F, int l) {
    LAS unsigned char* Ks = F.lds; LAS unsigned char* Vh = F.lds + 128 * RPITCH; LAS unsigned char* Sf = F.lds + 2 * 128 * RPITCH; LAS unsigned char* Sb = F.lds + 3 * 128 * RPITCH;
    const bf16* QB = WSP(bf16, WS_QB); const bf16* KB = WSP(bf16, WS_KB); const bf16* VB = WSP(bf16, WS_VB); const bf16* GB = WSP(bf16, WS_GB);
    const unsigned char* SFg = WSP(unsigned char, WS_SF); const unsigned char* SBg = WSP(unsigned char, WS_SB); unsigned char* MIX = WSP(unsigned char, WS_MIX);
    const int w = F.wave;
    const bool last = (l == DEPTH - 1);
    const int NU = last ? 16 * 64 : 16 * NCH, per = last ? 64 : NCH, cofs = last ? 2 : 0;
    int j = F.bid;
    if (j >= NU) return;
    v4u rk[4], rv[4]; v2u rf[4], rb[4];
    { const int bh = j / per, cidx = cofs + j % per, row0 = chunk_row0(bh >> 2, cidx), h = bh & 3; const size_t so = (size_t)(bh * NCH + cidx) * DV * DK;
      ld128(rk, KB + (size_t)row0 * QKW + h * DK, QKW, F.tid); ld128(rv, VB + (size_t)row0 * RWD + h * DV, RWD, F.tid); ld128f8(rf, SFg + so, F.tid); ld128f8(rb, SBg + so, F.tid); }
    for (; j < NU; j += F.G) {
        const int bh = j / per, cidx = cofs + j % per, b = bh >> 2, h = bh & 3;
        int tid = F.tid; asm volatile("" : "+v"(tid));
        const int lane = tid & 63, g = lane >> 4, i = lane & 15, q = i >> 2, p = i & 3;
        const int row0 = chunk_row0(b, cidx), c = 16 * w + i, r = row0 + c;
        const float lgf = logsig(IN_(9)[l * NH + h]), lgb = logsig(IN_(10)[l * NH + h]);
        const size_t so = (size_t)(bh * NCH + cidx) * DV * DK;
        v4u qv[4];
        const float qfs = 4.f * fexp((float)(c + 1) * lgf), qbs = 4.f * fexp((float)(128 - c) * lgb);
#pragma unroll
        for (int uu = 0; uu < 4; ++uu) qv[uu] = *(const v4u*)(QB + (size_t)r * QKW + h * DK + 32 * uu + 8 * g);
        st128(Ks, rk, tid); st128(Vh, rv, tid); st128f8(Sf, rf, tid); st128f8(Sb, rb, tid);
        __syncthreads();
        ld128(rv, VB + (size_t)row0 * RWD + h * DV + 128, RWD, tid); ld128f8(rf, SFg + so + (size_t)128 * DK, tid); ld128f8(rb, SBg + so + (size_t)128 * DK, tid);
        asm volatile("" ::: "memory");
        v4u pf[4];
        f32x4 acc[2][8];
        v2u gq[16];
        {
            f32x4 sc[8];
#pragma unroll
            for (int st = 0; st < 8; ++st) { sc[st] = (f32x4){0.f, 0.f, 0.f, 0.f};
#pragma unroll
                for (int uu = 0; uu < 4; ++uu) { const bf16x8 kf = *(const LAS bf16x8*)(Ks + (16 * st + i) * RPITCH + (32 * uu + 8 * g) * 2);
                    sc[st] = __builtin_amdgcn_mfma_f32_16x16x32_bf16(kf, __builtin_bit_cast(bf16x8, qv[uu]), sc[st], 0, 0, 0); }
                asm volatile("" ::: "memory"); }
#pragma unroll
            for (int st = 0; st < 8; ++st)
#pragma unroll
                for (int rg = 0; rg < 4; ++rg) { const int s = 16 * st + 4 * g + rg; const float m = fexp(c >= s ? (float)(c - s) * lgf : (float)(s - c) * lgb); sc[st][rg] *= m; }
#pragma unroll
            for (int uu = 0; uu < 4; ++uu) { pf[uu].x = pk2(sc[2 * uu][0], sc[2 * uu][1]); pf[uu].y = pk2(sc[2 * uu][2], sc[2 * uu][3]); pf[uu].z = pk2(sc[2 * uu + 1][0], sc[2 * uu + 1][1]); pf[uu].w = pk2(sc[2 * uu + 1][2], sc[2 * uu + 1][3]); }
        }
#pragma unroll
        for (int eh = 0; eh < 2; ++eh) {
            if (eh == 1) {
                __syncthreads();
                st128(Vh, rv, tid); st128f8(Sf, rf, tid); st128f8(Sb, rb, tid);
                __syncthreads();
                const int jn = j + F.G;
                if (jn < NU) { const int bh2 = jn / per, cidx2 = cofs + jn % per, row2 = chunk_row0(bh2 >> 2, cidx2), h2 = bh2 & 3; const size_t so2 = (size_t)(bh2 * NCH + cidx2) * DV * DK;
                    ld128(rk, KB + (size_t)row2 * QKW + h2 * DK, QKW, tid); ld128(rv, VB + (size_t)row2 * RWD + h2 * DV, RWD, tid); ld128f8(rf, SFg + so2, tid); ld128f8(rb, SBg + so2, tid); }
#pragma unroll
                for (int e2 = 0; e2 < 16; ++e2) gq[e2] = *(const v2u*)(GB + (size_t)r * RWD + h * DV + 128 * (e2 >> 3) + 16 * (e2 & 7) + 4 * g);
                asm volatile("" ::: "memory");
            }
#pragma unroll
            for (int et = 0; et < 8; ++et) {
                f32x4 a = (f32x4){0.f, 0.f, 0.f, 0.f};
#pragma unroll
                for (int uu = 0; uu < 4; ++uu) {
                    const bf16x8 vf = trpair(Vh + (32 * uu + 4 * g + q) * RPITCH + (16 * et + 4 * p) * 2, 16 * RPITCH);
                    a = __builtin_amdgcn_mfma_f32_16x16x32_bf16(vf, __builtin_bit_cast(bf16x8, pf[uu]), a, 0, 0, 0); }
                f32x4 xf = (f32x4){0.f, 0.f, 0.f, 0.f}, xb = xf;
#pragma unroll
                for (int uu = 0; uu < 4; ++uu) { const bf16x8 sf = *(const LAS bf16x8*)(Sf + (16 * et + i) * RPITCH + (32 * uu + 8 * g) * 2);
                    xf = __builtin_amdgcn_mfma_f32_16x16x32_bf16(sf, __builtin_bit_cast(bf16x8, qv[uu]), xf, 0, 0, 0); }
#pragma unroll
                for (int uu = 0; uu < 4; ++uu) { const bf16x8 sb = *(const LAS bf16x8*)(Sb + (16 * et + i) * RPITCH + (32 * uu + 8 * g) * 2);
                    xb = __builtin_amdgcn_mfma_f32_16x16x32_bf16(sb, __builtin_bit_cast(bf16x8, qv[uu]), xb, 0, 0, 0); }
                acc[eh][et] = a + qfs * xf + qbs * xb;
                asm volatile("" ::: "memory");
            }
        }
        float ss = 0.f;
#pragma unroll
        for (int eh = 0; eh < 2; ++eh)
#pragma unroll
            for (int et = 0; et < 8; ++et) { const f32x4 a = acc[eh][et]; ss += (a[0] * a[0] + a[1] * a[1]) + (a[2] * a[2] + a[3] * a[3]); }
        ss += shx_f(ss, 16, lane); ss += shx_f(ss, 32, lane);
        const float rn = __builtin_amdgcn_rsqf(ss * (1.f / DV) + EPS);
#pragma unroll
        for (int eh = 0; eh < 2; ++eh)
#pragma unroll
            for (int et = 0; et < 8; ++et) { const int ecol = h * DV + 128 * eh + 16 * et + 4 * g; const v2u gv = gq[eh * 8 + et];
                const float g0 = bflo(gv.x), g1 = bfhi(gv.x), g2 = bflo(gv.y), g3 = bfhi(gv.y); const f32x4 a = acc[eh][et] * rn;
                int o = __builtin_amdgcn_cvt_pk_fp8_f32(g0 * fsigm(g0) * a[0], g1 * fsigm(g1) * a[1], 0, false); o = __builtin_amdgcn_cvt_pk_fp8_f32(g2 * fsigm(g2) * a[2], g3 * fsigm(g3) * a[3], o, true);
                *(int*)(MIX + (size_t)r * MIXW + ecol) = o; if (et & 1) asm volatile("" ::: "memory"); }
        __syncthreads();
    }
}

constexpr int RWP = 2064;
__device__ __forceinline__ void top4_of8(const float (&v)[8], const int (&id)[8], float (&tv)[4], int (&ti)[4]) {
    float w[8];
#pragma unroll
    for (int k = 0; k < 8; ++k) w[k] = v[k];
#pragma unroll
    for (int k = 0; k < 4; ++k) { float bv = w[0]; int bi = id[0]; int bp = 0;
#pragma unroll
        for (int m = 1; m < 8; ++m) { const bool better = w[m] > bv || (w[m] == bv && id[m] < bi); bv = better ? w[m] : bv; bi = better ? id[m] : bi; bp = better ? m : bp; }
        tv[k] = bv; ti[k] = bi;
#pragma unroll
        for (int m = 0; m < 8; ++m) w[m] = (m == bp) ? -3.0e38f : w[m]; }
}
__device__ __forceinline__ void router_phase(Frame& F, int l) {
    LAS unsigned char* WH = F.lds; LAS unsigned char* WL = F.lds + NE * RWP;
    LAS int* lcnt = (LAS int*)(F.lds + 2 * NE * RWP); LAS int* lbase = lcnt + 32;
    LAS unsigned char* le = (LAS unsigned char*)(lcnt + 64); LAS unsigned short* lrk = (LAS unsigned short*)(le + 1024);
    LAS float* PRM = (LAS float*)(F.lds + 135168);
    const int NR = (l == DEPTH - 1) ? TL : TT; const int ntile = NR / 16;
    const int tb = (int)(((long)F.bid * ntile) / F.G), te = (int)(((long)(F.bid + 1) * ntile) / F.G);
    const int lane = F.lane, g = lane >> 4, i = lane & 15;
    const bf16* X = WSP(bf16, WS_X); unsigned char* HB8 = WSP(unsigned char, WS_HB8); const float* MODV = WSP(float, WS_MODV);
    int* ae = WSP(int, WS_ASG); int* ark = WSP(int, WS_ASG + 1 * MiB); float* aw = WSP(float, WS_ASG + 3 * MiB);
    { const v4u* src = WSP(v4u, WS_RWHL) + (size_t)l * 2 * NE * 128;
#pragma unroll
      for (int it = 0; it < 16; ++it) { const int pc = F.tid + 512 * it, hl = pc >> 12, e = (pc >> 7) & 31, c16 = pc & 127; *(LAS v4u*)(F.lds + hl * NE * RWP + e * RWP + c16 * 16) = src[pc]; } }
    const int s_lo = (16 * tb) < TL ? ((16 * tb) >> 13) : 4, s_hi = (16 * te - 1) < TL ? ((16 * te - 1) >> 13) : 4;
    { const float* nm = IN_(7) + (size_t)l * D;
#pragma unroll
      for (int it = 0; it < 4; ++it) { const int idx = F.tid + 512 * it, seg = idx >> 10, col = idx & 1023; const float* mv = MODV + (size_t)(l * 5 + (seg ? s_hi : s_lo)) * 6144;
          PRM[seg * 2048 + col] = nm[col] * (1.f + mv[4 * 1024 + col]); PRM[seg * 2048 + 1024 + col] = mv[3 * 1024 + col]; } }
    if (F.tid < 64) lcnt[F.tid] = 0;
    if (te - tb > 9 && F.tid == 0) atomicAdd(&F.ctl[CW_ERR], 1u);
    __syncthreads();
    for (int tile = tb + F.wave; tile < te; tile += NWAVES) {
        const int r = 16 * tile + i; const int s = r < TL ? (r >> 13) : 4;
        const LAS float* pa = PRM + ((s == s_lo) ? 0 : 2048) + 8 * g; const LAS float* ps = pa + 1024;
        const v4u* xp = (const v4u*)(X + (size_t)r * D) + g;
        v4u xr[32];
#pragma unroll
        for (int u = 0; u < 32; ++u) xr[u] = xp[4 * u];
        float ss = 0.f;
#pragma unroll
        for (int u = 0; u < 32; ++u) { const v4u x = xr[u]; const float a0 = bflo(x.x), a1 = bfhi(x.x), a2 = bflo(x.y), a3 = bfhi(x.y), c0 = bflo(x.z), c1 = bfhi(x.z), c2 = bflo(x.w), c3 = bfhi(x.w);
            ss += (a0 * a0 + a1 * a1) + (a2 * a2 + a3 * a3) + (c0 * c0 + c1 * c1) + (c2 * c2 + c3 * c3); }
        ss += shx_f(ss, 16, lane); ss += shx_f(ss, 32, lane);
        const float rms = 1.f / sqrtf(ss * (1.f / D) + EPS);
#pragma unroll
        for (int u = 0; u < 32; ++u) asm volatile("" : "+v"(xr[u]));
        f32x4 acc[2]; acc[0] = (f32x4){0.f, 0.f, 0.f, 0.f}; acc[1] = acc[0];
#pragma unroll
        for (int u = 0; u < 32; ++u) {
            const int col = 32 * u + 8 * g;
            const v4u xx = xr[u]; const f32x4 xa = (f32x4){bflo(xx.x), bfhi(xx.x), bflo(xx.y), bfhi(xx.y)}, xb = (f32x4){bflo(xx.z), bfhi(xx.z), bflo(xx.w), bfhi(xx.w)};
            const f32x4 ga = *(const LAS f32x4*)(pa + 32 * u), gb = *(const LAS f32x4*)(pa + 32 * u + 4), ha = *(const LAS f32x4*)(ps + 32 * u), hb = *(const LAS f32x4*)(ps + 32 * u + 4);
            const f32x4 h0 = xa * rms * ga + ha, h1 = xb * rms * gb + hb;
            v4u hi, lo; hi.x = pk2(h0[0], h0[1]); hi.y = pk2(h0[2], h0[3]); hi.z = pk2(h1[0], h1[1]); hi.w = pk2(h1[2], h1[3]);
            lo.x = pk2(h0[0] - bflo(hi.x), h0[1] - bfhi(hi.x)); lo.y = pk2(h0[2] - bflo(hi.y), h0[3] - bfhi(hi.y)); lo.z = pk2(h1[0] - bflo(hi.z), h1[1] - bfhi(hi.z)); lo.w = pk2(h1[2] - bflo(hi.w), h1[3] - bfhi(hi.w));
            { const float f8[8] = {h0[0], h0[1], h0[2], h0[3], h1[0], h1[1], h1[2], h1[3]}; *(v2u*)(HB8 + (size_t)r * D + col) = pk8_fp8(f8); }
#pragma unroll
            for (int t = 0; t < 2; ++t) { const bf16x8 wh = *(const LAS bf16x8*)(WH + (16 * t + i) * RWP + col * 2), wl = *(const LAS bf16x8*)(WL + (16 * t + i) * RWP + col * 2);
                acc[t] = __builtin_amdgcn_mfma_f32_16x16x32_bf16(wh, __builtin_bit_cast(bf16x8, hi), acc[t], 0, 0, 0);
                acc[t] = __builtin_amdgcn_mfma_f32_16x16x32_bf16(wh, __builtin_bit_cast(bf16x8, lo), acc[t], 0, 0, 0);
                acc[t] = __builtin_amdgcn_mfma_f32_16x16x32_bf16(wl, __builtin_bit_cast(bf16x8, hi), acc[t], 0, 0, 0); }
            asm volatile("" ::: "memory");
        }
        float v8[8]; int id8[8];
#pragma unroll
        for (int t = 0; t < 2; ++t)
#pragma unroll
            for (int rg = 0; rg < 4; ++rg) { const int e = 16 * t + 4 * g + rg; id8[4 * t + rg] = e; v8[4 * t + rg] = acc[t][rg] + IN_(14)[l * NE + e]; }
        float tv[4]; int ti[4];
        top4_of8(v8, id8, tv, ti);
#pragma unroll
        for (int step = 16; step <= 32; step <<= 1) {
#pragma unroll
            for (int k = 0; k < 4; ++k) { v8[k] = tv[k]; id8[k] = ti[k]; v8[4 + k] = shx_f(tv[k], step, lane); id8[4 + k] = shx_i(ti[k], step, lane); }
            top4_of8(v8, id8, tv, ti);
        }
        const float e1 = expf(tv[1] - tv[0]), e2 = expf(tv[2] - tv[0]), e3 = expf(tv[3] - tv[0]); const float inv = 1.f / (1.f + e1 + e2 + e3);
        if (lane < 16) {
            const int rl = 16 * (tile - tb) + i; const float wk[4] = {inv, e1 * inv, e2 * inv, e3 * inv};
#pragma unroll
            for (int k = 0; k < 4; ++k) { const int e = ti[k]; const int lr = __hip_atomic_fetch_add(lcnt + e, 1, __ATOMIC_RELAXED, __HIP_MEMORY_SCOPE_WORKGROUP);
                le[rl * 4 + k] = (unsigned char)e; lrk[rl * 4 + k] = (unsigned short)lr; ae[(size_t)r * 4 + k] = e; aw[(size_t)r * 4 + k] = wk[k]; }
        }
    }
    __syncthreads();
    if (F.tid < NE) lbase[F.tid] = (int)atomicAdd(&F.ctl[CW_GCNT + (((MK_MULTI && F.ka->probe == 3) ? l + 4 : l) * 32 + F.tid) * 64], (unsigned)lcnt[F.tid]);
    __syncthreads();
    { int* tlist = WSP(int, WS_TLIST);
      for (int a = F.tid; a < (te - tb) * 64; a += 512) { const int e = le[a], rk = lbase[e] + (int)lrk[a]; ark[(size_t)tb * 64 + a] = rk; tlist[(size_t)e * TT + rk] = 16 * tb + (a >> 2); } }
}
#ifndef FILL_WIN
#define FILL_WIN 1
#define FILL_R3 1
#define FILL_WOUT 1
#endif
#if defined(BAR_EARLY_WB)
#define EARLY_WB() do { asm volatile("s_waitcnt vmcnt(0)" ::: "memory"); __syncthreads(); if (threadIdx.x == 0) { __builtin_amdgcn_fence(__ATOMIC_RELEASE, "agent"); asm volatile("s_waitcnt vmcnt(0)" ::: "memory"); } } while (0)
#else
#define EARLY_WB() do { } while (0)
#endif
#ifndef GP_ALIGN
#define GP_ALIGN true
#endif
#ifndef GP_SP2
#define GP_SP2 true
#endif
constexpr int NPH = 9, NSTEPS = 1 + DEPTH * NPH + 1;
template <int PB> __global__ void __launch_bounds__(NWAVES * 64, 2) mk_fwd_t(Args args) {
    extern __shared__ __attribute__((aligned(16))) unsigned char lds[];
    const int wave0 = __builtin_amdgcn_readfirstlane((int)threadIdx.x >> 6);
    for (int u = threadIdx.x; u < (LDS_BYTES - MISC_OFF) / 4; u += NWAVES * 64) ((LAS unsigned*)((LAS unsigned char*)lds + MISC_OFF))[u] = 0u;
    __syncthreads();
#if MK_MULTI
#define GRID_BAR() do { } while (0)
#else
    (void)xcd_barrier_post((unsigned*)args.ws + CW_BAR, (volatile LAS unsigned*)((LAS unsigned char*)lds + MISC_OFF) + 8);
#define GRID_BAR() do { const CAS Args* kb_ = (const CAS Args*)__builtin_amdgcn_kernarg_segment_ptr(); asm volatile("" : "+s"(kb_)); XcdBarrier bar_; bar_.bar = (unsigned*)kb_->ws + CW_BAR; bar_.x = xb_xcc_id(); \
        bar_.st = (volatile LAS unsigned*)((LAS unsigned char*)lds + MISC_OFF) + 8; EARLY_WB(); xcd_barrier(bar_); } while (0)
#endif
#if MK_MULTI
    const int lo = args.ph_lo, hi = args.ph_hi;
#else
    constexpr int lo = 0, hi = NSTEPS;
#endif
#ifndef PH_MASK
#define PH_MASK 0xFFFF
#endif
#define PON(j) (((PH_MASK) >> (j)) & 1)
#define IN(k) (lo <= (k) && (k) < hi)
#define SEAM(k) do { if (IN(k) && IN((k) + 1)) GRID_BAR(); } while (0)

    if (PON(10) && IN(0)) { MKFRAME(F); p0_prologue(F); SEAM(0); }
    for (int l = 0; l < DEPTH; ++l) {
        const int sb = 1 + l * NPH;
        const bool last = (l == DEPTH - 1);
        if (PON(0) && IN(sb + 0)) { MKFRAME(F); row_phase<false>(F, l); SEAM(sb + 0); }
        if (PON(1) && IN(sb + 1)) { MKFRAME(F);
            pg8::Gemm g{WSP(bf16, WS_HB), WSP(bf16, WS_WINT) + (size_t)l * INW * 1024, TT, INW, (MK_MULTI && PB == 4) ? D / 2 : D}; pg8::StaticOrder S; S.init(TT, INW, F.G, F.bid);
            EpiWin E{F.ws, PB};
            pg8::gemm_phase<EpiWin, pg8::StaticOrder, GP_ALIGN, GP_SP2>(F.lds, g, S, E, F.tid);
            { MKFRAME(F2); if (9 * F2.G + F2.bid >= (TT / 256) * (INW / 256)) convert_fill(F2, l, 1, FILL_WIN); }
            SEAM(sb + 1);
        }
        if (PON(2) && IN(sb + 2)) { MKFRAME(F); r1_phase(F, l); conv_phase(F, l); SEAM(sb + 2); }
        if (PON(3) && IN(sb + 3)) { MKFRAME(F); scan_phase(F, l); SEAM(sb + 3); }
        if (PON(4) && IN(sb + 4)) { MKFRAME(F); r3_phase(F, l); { MKFRAME(F2); if (4 * F2.G + F2.bid >= 16 * NCH) { __syncthreads(); convert_fill(F2, l, 1, FILL_R3); } } SEAM(sb + 4); }
        if (PON(5) && IN(sb + 5)) { MKFRAME(F);
            const int M = last ? TL : TT;
            pg8::Gemm g{WSP(bf16, WS_MIX), (const bf16*)(WSP(unsigned char, WS_WOUTT) + (size_t)l * 1024 * MIXW), M, D, MIXW / 2}; pg8::StaticOrder S; S.init(M, D, F.G, F.bid);
            EpiWout E{WSP(bf16, WS_X), WSP(bf16, WS_XB), WSP(bf16, WS_G1H) + (size_t)l * 5 * 1024};
            pg8::gemm_phase<EpiWout, pg8::StaticOrder, GP_ALIGN, GP_SP2, true>(F.lds, g, S, E, F.tid);
            { MKFRAME(F2); if (2 * F2.G + F2.bid >= (TT / 256) * (D / 256)) convert_fill(F2, l, 1, FILL_WOUT); }
            SEAM(sb + 5);
        }
        if (PON(6) && IN(sb + 6)) { MKFRAME(F); router_phase(F, l); { MKFRAME(F2); __syncthreads(); convert_fill(F2, l, 1, -1); } SEAM(sb + 6); }
        if (PON(7) && IN(sb + 7)) { MKFRAME(F);
            moe_offsets(F, l);
            const LAS int* toff = (const LAS int*)(F.lds + MISC_OFF + 256); const int NT = toff[32];
            pg8::Gemm g{(const bf16*)WSP(unsigned char, WS_HB8), (const bf16*)(WSP(unsigned char, WS_WUPT) + (size_t)l * NE * 2048 * 1024), NT * 256, NE * 2048, (MK_MULTI && PB == 4) ? D / 4 : D / 2};
            MoeOrder S{toff, NT, 8, 3, F.G, F.bid, WSP(int, WS_TLIST)};
            EpiUp E{WSP(unsigned char, WS_ACT), WSP(bf16, WS_BUPH) + (size_t)l * NE * 2048, PB};
            pg8::gemm_phase<EpiUp, MoeOrder, GP_ALIGN, GP_SP2, true, true>(F.lds, g, S, E, F.tid);
            SEAM(sb + 7);
        }
        if (PON(8) && IN(sb + 8)) { MKFRAME(F);
            if (MK_MULTI) moe_offsets(F, l);
            const LAS int* toff = (const LAS int*)(F.lds + MISC_OFF + 256); const int NT = toff[32];
            pg8::Gemm g{WSP(bf16, WS_ACT), (const bf16*)(WSP(unsigned char, WS_WDNT) + (size_t)l * NE * 1024 * 1024), NT * 256, NE * 1024, (MK_MULTI && PB == 4) ? DFF / 4 : DFF / 2};
            MoeOrder S{toff, NT, 4, 2, F.G, F.bid, nullptr};
            EpiDown E{WSP(unsigned char, WS_YB), WSP(bf16, WS_BDNH) + (size_t)l * NE * 1024, PB};
            pg8::gemm_phase<EpiDown, MoeOrder, GP_ALIGN, GP_SP2, true>(F.lds, g, S, E, F.tid);
            SEAM(sb + 8);
        }
    }
    if (PON(11) && IN(NSTEPS - 1)) { MKFRAME(F); row_phase<true>(F, DEPTH); }
#undef IN
#undef SEAM
}

#define mk_fwd mk_fwd_t<0>
extern "C" void kernel_launch(void* const* d_in, const int* in_sizes, int n_in, void* d_out, int out_size, void* d_ws, size_t ws_size, hipStream_t stream) {
    static int grid = 0;
    if (grid == 0) {
        if (n_in != 20 || out_size != TL * D || ws_size < WS_END) { fprintf(stderr, "kernel_launch: unexpected shapes (n_in %d out %d ws %zu)\n", n_in, out_size, ws_size); grid = -1; return; }
        int dev = 0, cus = 0, per_cu = 0;
        if (hipGetDevice(&dev) != hipSuccess || hipDeviceGetAttribute(&cus, hipDeviceAttributeMultiprocessorCount, dev) != hipSuccess) { grid = -1; return; }
#if MK_MULTI && defined(DUP_PROBE)
        (void)hipFuncSetAttribute((const void*)mk_fwd_t<DUP_PROBE>, hipFuncAttributeMaxDynamicSharedMemorySize, LDS_BYTES);
#endif
        if (hipFuncSetAttribute((const void*)mk_fwd, hipFuncAttributeMaxDynamicSharedMemorySize, LDS_BYTES) != hipSuccess) { fprintf(stderr, "kernel_launch: hipFuncSetAttribute failed\n"); grid = -1; return; }
        if (hipOccupancyMaxActiveBlocksPerMultiprocessor(&per_cu, (const void*)mk_fwd, NWAVES * 64, LDS_BYTES) != hipSuccess || per_cu < 1) fprintf(stderr, "kernel_launch: occupancy query reports %d blocks per CU\n", per_cu);
        (void)hipGetLastError();
        grid = cus;
    }
    if (grid < 0) return;
    if (hipMemsetAsync((char*)d_ws + WS_CTL, 0, CTL_ZERO_BYTES, stream) != hipSuccess) return;
    Args a{};
    for (int i = 0; i < 20; ++i) a.in[i] = (const float*)d_in[i];
    a.out = (float*)d_out; a.ws = (unsigned char*)d_ws;
#if MK_MULTI
#ifndef DUP_MASK
#define DUP_MASK 0
#endif
    for (int st = 0; st < NSTEPS; ++st) { a.ph_lo = st; a.ph_hi = st + 1; hipLaunchKernelGGL(mk_fwd, dim3(grid), dim3(NWAVES * 64), LDS_BYTES, stream, a);
        const int j = (st == 0) ? 10 : (st == NSTEPS - 1 ? 11 : (st - 1) % NPH);
#ifndef DUP_PROBE
#define DUP_PROBE 0
#endif
        if ((DUP_MASK >> j) & 1) { a.probe = DUP_PROBE; hipLaunchKernelGGL(mk_fwd_t<DUP_PROBE>, dim3(grid), dim3(NWAVES * 64), LDS_BYTES, stream, a); a.probe = 0; } }
#else
    a.ph_lo = 0; a.ph_hi = NSTEPS;
    hipLaunchKernelGGL(mk_fwd, dim3(grid), dim3(NWAVES * 64), LDS_BYTES, stream, a);
#endif
    const hipError_t le = hipPeekAtLastError();
    if (le != hipSuccess) fprintf(stderr, "kernel_launch: launch failed: %s\n", hipGetErrorName(le));
}
```
